# Optimizing an MI355X kernel written in HIP

```python
import jax, jax.numpy as jnp
from jax import lax
import numpy as np

D_MODEL = 1024
BATCH = 8
SEQ = 2048
DEPTH = 1

HEAD_DIM = 64
NA_HEADS = 8
SWA_HEADS = 8
SWA_KV_HEADS = 2
A_WIDTH = NA_HEADS * HEAD_DIM
B_WIDTH = SWA_HEADS * HEAD_DIM
B_KV_WIDTH = SWA_KV_HEADS * HEAD_DIM
MIX_WIDTH = A_WIDTH + B_WIDTH
IN_WIDTH = 3 * A_WIDTH + B_WIDTH + 2 * B_KV_WIDTH
GRID_W = 64
NA_ROWS_MAX = 8
NA_COLS = 16
NA_QROWS = 2
NA_QCOLS = 16
NA_HCOLS = NA_COLS + NA_QCOLS
SWA_WINDOW = 128
SWA_BLOCK = 128
ROPE_THETA = 500000.0
ROPE_DIM = HEAD_DIM // 4
D_FF = -(-8 * D_MODEL // (3 * 256)) * 256
RMS_EPS = 1e-6
NEG_INF = -1e30

kernel_name = "hybrid_natten_swa_sink_encoder_block"


def rmsnorm(x, g):
    xf = x.astype(jnp.float32)
    y = xf * lax.rsqrt(jnp.mean(xf * xf, axis=-1, keepdims=True) + RMS_EPS)
    return (y * g.astype(jnp.float32)).astype(x.dtype)


def partial_rope(x, pos):
    inv_freq = ROPE_THETA ** (-jnp.arange(0, ROPE_DIM, 2, dtype=jnp.float32) / ROPE_DIM)
    ang = pos.astype(jnp.float32)[:, None] * inv_freq[None, :]
    cos = jnp.cos(ang)[None, :, None, :]
    sin = jnp.sin(ang)[None, :, None, :]
    xr = x[..., :ROPE_DIM].astype(jnp.float32)
    x1, x2 = xr[..., : ROPE_DIM // 2], xr[..., ROPE_DIM // 2:]
    rot = jnp.concatenate([x1 * cos - x2 * sin, x2 * cos + x1 * sin], axis=-1)
    return jnp.concatenate([rot.astype(x.dtype), x[..., ROPE_DIM:]], axis=-1)


def _axis_windows(n, k, q_blk, halo):
    nb = n // q_blk
    q_pos = np.arange(n).reshape(nb, q_blk)
    start = np.clip(q_pos - k // 2, 0, n - k)
    h0 = np.clip(q_pos[:, 0] - k // 2, 0, n - halo)
    k_pos = h0[:, None] + np.arange(halo)[None, :]
    ok = (k_pos[:, None, :] >= start[:, :, None]) & (k_pos[:, None, :] < start[:, :, None] + k)
    off = k_pos[:, None, :] - q_pos[:, :, None]
    return q_pos, k_pos, ok, off


def neighbourhood_attention(q, k, v, rpb):
    b, s, h, d = q.shape
    rows = s // GRID_W
    kr = min(NA_ROWS_MAX, rows)
    hr = min(kr + NA_QROWS, rows)
    _, r_keys, r_ok, r_off = _axis_windows(rows, kr, NA_QROWS, hr)
    _, c_keys, c_ok, c_off = _axis_windows(GRID_W, NA_COLS, NA_QCOLS, NA_HCOLS)
    rb, cb = rows // NA_QROWS, GRID_W // NA_QCOLS
    nq, nk = NA_QROWS * NA_QCOLS, hr * NA_HCOLS

    key_idx = (r_keys[:, None, :, None] * GRID_W + c_keys[None, :, None, :]).astype(np.int32)
    key_idx = key_idx.reshape(-1)
    kb = jnp.take(k, key_idx, axis=1).reshape(b, rb, cb, nk, h, d)
    vb = jnp.take(v, key_idx, axis=1).reshape(b, rb, cb, nk, h, d)
    qb = q.reshape(b, rb, NA_QROWS, cb, NA_QCOLS, h, d).transpose(0, 1, 3, 2, 4, 5, 6)
    qb = qb.reshape(b, rb, cb, nq, h, d)

    mask = (r_ok[:, None, :, None, :, None] & c_ok[None, :, None, :, None, :]).reshape(rb, cb, nq, nk)
    r_idx = np.clip(r_off + NA_ROWS_MAX - 1, 0, 2 * NA_ROWS_MAX - 2).astype(np.int32)
    c_idx = np.clip(c_off + NA_COLS - 1, 0, 2 * NA_COLS - 2).astype(np.int32)
    bias = rpb[:, r_idx[:, None, :, None, :, None], c_idx[None, :, None, :, None, :]]
    bias = bias.reshape(h, rb, cb, nq, nk).transpose(1, 2, 0, 3, 4).astype(jnp.float32)

    scale = HEAD_DIM ** -0.5
    logits = jnp.einsum('bnmqhd,bnmkhd->bnmhqk', qb, kb).astype(jnp.float32) * scale + bias
    logits = jnp.where(mask[:, :, None], logits, NEG_INF)
    p = jax.nn.softmax(logits, axis=-1).astype(vb.dtype)
    o = jnp.einsum('bnmhqk,bnmkhd->bnmqhd', p, vb)
    o = o.reshape(b, rb, cb, NA_QROWS, NA_QCOLS, h, d).transpose(0, 1, 3, 2, 4, 5, 6)
    return o.reshape(b, s, h, d)


def windowed_gqa_sink(q, k, v, sink):
    b, s, hq, d = q.shape
    hkv = k.shape[2]
    g = hq // hkv
    nb = s // SWA_BLOCK
    qb = q.reshape(b, nb, SWA_BLOCK, hkv, g, d)

    def band(t):
        tp = jnp.pad(t, ((0, 0), (SWA_BLOCK, SWA_BLOCK), (0, 0), (0, 0)))
        tp = tp.reshape(b, nb + 2, SWA_BLOCK, hkv, d)
        return jnp.concatenate([tp[:, :-2], tp[:, 1:-1], tp[:, 2:]], axis=2)

    kb, vb = band(k), band(v)
    q_pos = np.arange(nb)[:, None] * SWA_BLOCK + np.arange(SWA_BLOCK)[None, :]
    k_pos = (np.arange(nb)[:, None] - 1) * SWA_BLOCK + np.arange(3 * SWA_BLOCK)[None, :]
    mask = ((np.abs(q_pos[:, :, None] - k_pos[:, None, :]) <= SWA_WINDOW)
            & (k_pos[:, None, :] >= 0) & (k_pos[:, None, :] < s))

    scale = HEAD_DIM ** -0.5
    logits = jnp.einsum('bnqkgd,bnjkd->bnkgqj', qb, kb).astype(jnp.float32) * scale
    logits = jnp.where(mask[None, :, None, None], logits, NEG_INF)
    sk = sink.astype(jnp.float32).reshape(hkv, g)[None, None, :, :, None, None]
    m = jnp.maximum(jnp.max(logits, axis=-1, keepdims=True), sk)
    p = jnp.exp(logits - m)
    denom = jnp.sum(p, axis=-1, keepdims=True) + jnp.exp(sk - m)
    p = (p / denom).astype(vb.dtype)
    o = jnp.einsum('bnkgqj,bnjkd->bnqkgd', p, vb)
    return o.reshape(b, s, hq, d)


def setup_inputs(seed: int = 0) -> dict:
    key = jax.random.key(seed)
    ks = jax.random.split(key, 14)
    f32 = jnp.float32

    def nrm(k, shape, scale):
        return jax.random.normal(k, shape, f32) * scale

    def gain(k, shape):
        return 1.0 + 0.05 * jax.random.normal(k, shape, f32)

    return {
        "x": jax.random.normal(ks[0], (BATCH, SEQ, D_MODEL), f32),
        "g_norm_mix": gain(ks[1], (DEPTH, D_MODEL)),
        "w_in": nrm(ks[2], (DEPTH, D_MODEL, IN_WIDTH), D_MODEL ** -0.5),
        "na_rpb": nrm(ks[3], (DEPTH, NA_HEADS, 2 * NA_ROWS_MAX - 1, 2 * NA_COLS - 1), 0.2),
        "swa_sink": nrm(ks[4], (DEPTH, SWA_HEADS), 0.5),
        "g_out_na": gain(ks[5], (DEPTH, A_WIDTH)),
        "g_out_swa": gain(ks[6], (DEPTH, B_WIDTH)),
        "w_out": nrm(ks[7], (DEPTH, MIX_WIDTH, D_MODEL), MIX_WIDTH ** -0.5),
        "g_norm_ffn": gain(ks[8], (DEPTH, D_MODEL)),
        "w_gate": nrm(ks[9], (DEPTH, D_MODEL, D_FF), D_MODEL ** -0.5),
        "w_up": nrm(ks[10], (DEPTH, D_MODEL, D_FF), D_MODEL ** -0.5),
        "w_down": nrm(ks[11], (DEPTH, D_FF, D_MODEL), D_FF ** -0.5),
        "g_final": gain(ks[12], (D_MODEL,)),
    }


def reference(x, g_norm_mix, w_in, na_rpb, swa_sink, g_out_na, g_out_swa, w_out,
              g_norm_ffn, w_gate, w_up, w_down, g_final):
    b, s, _ = x.shape
    pos = jnp.arange(s, dtype=jnp.int32)
    split_at = [A_WIDTH, 2 * A_WIDTH, 3 * A_WIDTH, 3 * A_WIDTH + B_WIDTH,
                3 * A_WIDTH + B_WIDTH + B_KV_WIDTH]
    for l in range(DEPTH):
        h = rmsnorm(x, g_norm_mix[l])
        proj = h @ w_in[l]
        qa, ka, va, qb, kb, vb = jnp.split(proj, split_at, axis=-1)
        qa = qa.reshape(b, s, NA_HEADS, HEAD_DIM)
        ka = ka.reshape(b, s, NA_HEADS, HEAD_DIM)
        va = va.reshape(b, s, NA_HEADS, HEAD_DIM)
        qb = partial_rope(qb.reshape(b, s, SWA_HEADS, HEAD_DIM), pos)
        kb = partial_rope(kb.reshape(b, s, SWA_KV_HEADS, HEAD_DIM), pos)
        vb = vb.reshape(b, s, SWA_KV_HEADS, HEAD_DIM)

        oa = neighbourhood_attention(qa, ka, va, na_rpb[l]).reshape(b, s, A_WIDTH)
        ob = windowed_gqa_sink(qb, kb, vb, swa_sink[l]).reshape(b, s, B_WIDTH)
        o = jnp.concatenate([rmsnorm(oa, g_out_na[l]), rmsnorm(ob, g_out_swa[l])], axis=-1)
        x = x + o @ w_out[l]

        h = rmsnorm(x, g_norm_ffn[l])
        x = x + (jax.nn.silu(h @ w_gate[l]) * (h @ w_up[l])) @ w_down[l]
    return rmsnorm(x, g_final)
```

```cpp
#include <hip/hip_runtime.h>
#include <math.h>

namespace {
constexpr int BATCH = 8, SEQ = 2048, DM = 1024, M_TOK = BATCH * SEQ;
constexpr int NIN = 2304, DFF = 2816;
constexpr int GRID_W = 64;
constexpr float RMS_EPS = 1e-6f;

__global__ void __launch_bounds__(256) rmsnorm1024_k(const float* x, const float* g, float* y) {
    __shared__ float red[4];
    const int row = blockIdx.x, t = threadIdx.x;
    const float4 v = ((const float4*)(x + (size_t)row * DM))[t];
    float s = v.x * v.x + v.y * v.y + v.z * v.z + v.w * v.w;
    for (int o = 32; o > 0; o >>= 1) s += __shfl_xor(s, o);
    if ((t & 63) == 0) red[t >> 6] = s;
    __syncthreads();
    const float tot = red[0] + red[1] + red[2] + red[3];
    const float r = rsqrtf(tot * (1.0f / DM) + RMS_EPS);
    const float4 gv = ((const float4*)g)[t];
    float4 o; o.x = v.x * r * gv.x; o.y = v.y * r * gv.y; o.z = v.z * r * gv.z; o.w = v.w * r * gv.w;
    ((float4*)(y + (size_t)row * DM))[t] = o;
}

template <int MODE>
__global__ void __launch_bounds__(256) gemm_k(const float* __restrict__ A, const float* __restrict__ Bm, const float* __restrict__ B2,
                                              const float* R, float* C, int N, int K, int lda, int ldb, int ldc) {
    __shared__ float As[8][128 + 4];
    __shared__ float Bs[8][128];
    __shared__ float Bs2[MODE == 2 ? 8 : 1][128];
    const int tid = threadIdx.x, ty = tid >> 4, tx = tid & 15;
    const int m0 = blockIdx.y * 128, n0 = blockIdx.x * 128;
    float acc[8][8], acc2[MODE == 2 ? 8 : 1][8];
#pragma unroll
    for (int i = 0; i < 8; ++i)
#pragma unroll
        for (int j = 0; j < 8; ++j) acc[i][j] = 0.f;
    if (MODE == 2) {
#pragma unroll
        for (int i = 0; i < 8; ++i)
#pragma unroll
            for (int j = 0; j < 8; ++j) acc2[i][j] = 0.f;
    }
    const int ar = tid >> 1, ak = (tid & 1) * 4;
    const int bk = tid >> 5, bn = (tid & 31) * 4;
    for (int k0 = 0; k0 < K; k0 += 8) {
        const float4 av = *(const float4*)(A + (size_t)(m0 + ar) * lda + k0 + ak);
        const float4 bv = *(const float4*)(Bm + (size_t)(k0 + bk) * ldb + n0 + bn);
        float4 bv2;
        if (MODE == 2) bv2 = *(const float4*)(B2 + (size_t)(k0 + bk) * ldb + n0 + bn);
        __syncthreads();
        As[ak + 0][ar] = av.x; As[ak + 1][ar] = av.y; As[ak + 2][ar] = av.z; As[ak + 3][ar] = av.w;
        *(float4*)&Bs[bk][bn] = bv;
        if (MODE == 2) *(float4*)&Bs2[bk][bn] = bv2;
        __syncthreads();
#pragma unroll
        for (int k = 0; k < 8; ++k) {
            float a[8], b[8];
            const float4 a0 = *(const float4*)&As[k][ty * 4], a1 = *(const float4*)&As[k][64 + ty * 4];
            const float4 b0 = *(const float4*)&Bs[k][tx * 4], b1 = *(const float4*)&Bs[k][64 + tx * 4];
            a[0] = a0.x; a[1] = a0.y; a[2] = a0.z; a[3] = a0.w; a[4] = a1.x; a[5] = a1.y; a[6] = a1.z; a[7] = a1.w;
            b[0] = b0.x; b[1] = b0.y; b[2] = b0.z; b[3] = b0.w; b[4] = b1.x; b[5] = b1.y; b[6] = b1.z; b[7] = b1.w;
#pragma unroll
            for (int i = 0; i < 8; ++i)
#pragma unroll
                for (int j = 0; j < 8; ++j) acc[i][j] = fmaf(a[i], b[j], acc[i][j]);
            if (MODE == 2) {
                float c[8];
                const float4 c0 = *(const float4*)&Bs2[k][tx * 4], c1 = *(const float4*)&Bs2[k][64 + tx * 4];
                c[0] = c0.x; c[1] = c0.y; c[2] = c0.z; c[3] = c0.w; c[4] = c1.x; c[5] = c1.y; c[6] = c1.z; c[7] = c1.w;
#pragma unroll
                for (int i = 0; i < 8; ++i)
#pragma unroll
                    for (int j = 0; j < 8; ++j) acc2[i][j] = fmaf(a[i], c[j], acc2[i][j]);
            }
        }
    }
#pragma unroll
    for (int i = 0; i < 8; ++i) {
        const int row = m0 + (i < 4 ? ty * 4 + i : 64 + ty * 4 + (i - 4));
#pragma unroll
        for (int jh = 0; jh < 2; ++jh) {
            const int col = n0 + jh * 64 + tx * 4;
            float4 o;
            float v[4];
#pragma unroll
            for (int j = 0; j < 4; ++j) {
                float t = acc[i][jh * 4 + j];
                if (MODE == 2) { const float u = acc2[i][jh * 4 + j]; t = (t / (1.0f + expf(-t))) * u; }
                v[j] = t;
            }
            o.x = v[0]; o.y = v[1]; o.z = v[2]; o.w = v[3];
            if (MODE == 1) { const float4 r = *(const float4*)(R + (size_t)row * ldc + col); o.x += r.x; o.y += r.y; o.z += r.z; o.w += r.w; }
            *(float4*)(C + (size_t)row * ldc + col) = o;
        }
    }
}

__global__ void rope_k(float* proj) {
    const int idx = blockIdx.x * blockDim.x + threadIdx.x;
    if (idx >= M_TOK * 10 * 8) return;
    const int i = idx & 7, head = (idx >> 3) % 10, tok = idx / 80;
    const int pos = tok % SEQ;
    const int base = (head < 8) ? (1536 + head * 64) : (2048 + (head - 8) * 64);
    const float inv_freq = powf(500000.0f, -(float)(2 * i) / 16.0f);
    const float ang = (float)pos * inv_freq;
    float sn, cs; sincosf(ang, &sn, &cs);
    float* p = proj + (size_t)tok * NIN + base;
    const float x1 = p[i], x2 = p[i + 8];
    p[i] = x1 * cs - x2 * sn;
    p[i + 8] = x2 * cs + x1 * sn;
}

__device__ __forceinline__ float wave_max(float v) { for (int o = 32; o > 0; o >>= 1) v = fmaxf(v, __shfl_xor(v, o)); return v; }
__device__ __forceinline__ float wave_sum(float v) { for (int o = 32; o > 0; o >>= 1) v += __shfl_xor(v, o); return v; }

__global__ void __launch_bounds__(512) na_attn_k(const float* __restrict__ proj, const float* __restrict__ rpb, const float* __restrict__ gout, float* o) {
    __shared__ float qs[8][64];
    __shared__ float ps[8][128];
    __shared__ float ssq[8];
    const int tok = blockIdx.x, b = tok / SEQ, t = tok % SEQ, r = t / GRID_W, c = t % GRID_W;
    const int h = threadIdx.x >> 6, lane = threadIdx.x & 63;
    const int sr = min(max(r - 4, 0), 24), sc = min(max(c - 8, 0), 48);
    qs[h][lane] = proj[(size_t)tok * NIN + h * 64 + lane];
    __syncthreads();
    float lg[2];
#pragma unroll
    for (int j = 0; j < 2; ++j) {
        const int kk = lane + 64 * j, kr = sr + (kk >> 4), kc = sc + (kk & 15);
        const float* kp = proj + ((size_t)b * SEQ + kr * GRID_W + kc) * NIN + 512 + h * 64;
        float s = 0.f;
        for (int d = 0; d < 64; d += 4) { const float4 kv = *(const float4*)(kp + d); s += qs[h][d] * kv.x + qs[h][d + 1] * kv.y + qs[h][d + 2] * kv.z + qs[h][d + 3] * kv.w; }
        lg[j] = s * 0.125f + rpb[(h * 15 + (kr - r + 7)) * 31 + (kc - c + 15)];
    }
    const float mx = wave_max(fmaxf(lg[0], lg[1]));
    const float p0 = expf(lg[0] - mx), p1 = expf(lg[1] - mx);
    const float den = wave_sum(p0 + p1);
    ps[h][lane] = p0 / den; ps[h][lane + 64] = p1 / den;
    __syncthreads();
    float acc = 0.f;
    for (int kk = 0; kk < 128; ++kk) {
        const int kr = sr + (kk >> 4), kc = sc + (kk & 15);
        acc += ps[h][kk] * proj[((size_t)b * SEQ + kr * GRID_W + kc) * NIN + 1024 + h * 64 + lane];
    }
    const float sq = wave_sum(acc * acc);
    if (lane == 0) ssq[h] = sq;
    __syncthreads();
    float tot = 0.f;
    for (int i = 0; i < 8; ++i) tot += ssq[i];
    const float rs = rsqrtf(tot * (1.0f / 512.0f) + RMS_EPS);
    o[(size_t)tok * DM + h * 64 + lane] = acc * rs * gout[h * 64 + lane];
}

__global__ void __launch_bounds__(512) swa_attn_k(const float* __restrict__ proj, const float* __restrict__ sink, const float* __restrict__ gout, float* o) {
    __shared__ float qs[8][64];
    __shared__ float ps[8][320];
    __shared__ float ssq[8];
    const int tok = blockIdx.x, b = tok / SEQ, t = tok % SEQ;
    const int h = threadIdx.x >> 6, lane = threadIdx.x & 63, kvh = h >> 2;
    const int j0 = max(t - 128, 0), j1 = min(t + 128, SEQ - 1), nk = j1 - j0 + 1;
    qs[h][lane] = proj[(size_t)tok * NIN + 1536 + h * 64 + lane];
    __syncthreads();
    float lg[5]; float mx = sink[h];
#pragma unroll
    for (int p = 0; p < 5; ++p) {
        const int kk = lane + 64 * p;
        float s = -1e30f;
        if (kk < nk) {
            const float* kp = proj + ((size_t)b * SEQ + j0 + kk) * NIN + 2048 + kvh * 64;
            float a = 0.f;
            for (int d = 0; d < 64; d += 4) { const float4 kv = *(const float4*)(kp + d); a += qs[h][d] * kv.x + qs[h][d + 1] * kv.y + qs[h][d + 2] * kv.z + qs[h][d + 3] * kv.w; }
            s = a * 0.125f;
        }
        lg[p] = s; mx = fmaxf(mx, s);
    }
    mx = wave_max(mx);
    float sum = 0.f;
#pragma unroll
    for (int p = 0; p < 5; ++p) { const int kk = lane + 64 * p; const float e = (kk < nk) ? expf(lg[p] - mx) : 0.f; lg[p] = e; sum += e; }
    const float den = wave_sum(sum) + expf(sink[h] - mx);
#pragma unroll
    for (int p = 0; p < 5; ++p) ps[h][lane + 64 * p] = lg[p] / den;
    __syncthreads();
    float acc = 0.f;
    for (int kk = 0; kk < nk; ++kk) acc += ps[h][kk] * proj[((size_t)b * SEQ + j0 + kk) * NIN + 2176 + kvh * 64 + lane];
    const float sq = wave_sum(acc * acc);
    if (lane == 0) ssq[h] = sq;
    __syncthreads();
    float tot = 0.f;
    for (int i = 0; i < 8; ++i) tot += ssq[i];
    const float rs = rsqrtf(tot * (1.0f / 512.0f) + RMS_EPS);
    o[(size_t)tok * DM + 512 + h * 64 + lane] = acc * rs * gout[h * 64 + lane];
}
}

extern "C" void kernel_launch(void* const* d_in, const int* in_sizes, int n_in, void* d_out, int out_size, void* d_ws, size_t ws_size, hipStream_t stream) {
    const float* x = (const float*)d_in[0];
    const float* g_mix = (const float*)d_in[1];
    const float* w_in = (const float*)d_in[2];
    const float* rpb = (const float*)d_in[3];
    const float* sink = (const float*)d_in[4];
    const float* g_na = (const float*)d_in[5];
    const float* g_swa = (const float*)d_in[6];
    const float* w_out = (const float*)d_in[7];
    const float* g_ffn = (const float*)d_in[8];
    const float* w_gate = (const float*)d_in[9];
    const float* w_up = (const float*)d_in[10];
    const float* w_down = (const float*)d_in[11];
    const float* g_fin = (const float*)d_in[12];
    float* out = (float*)d_out;
    char* ws = (char*)d_ws;
    constexpr size_t MiB = 1u << 20;
    float* bufA = (float*)(ws);
    float* proj = (float*)(ws + 64 * MiB);
    float* x1 = (float*)(ws + 64 * MiB);
    float* act = (float*)(ws + 128 * MiB);

    rmsnorm1024_k<<<M_TOK, 256, 0, stream>>>(x, g_mix, bufA);
    gemm_k<0><<<dim3(NIN / 128, M_TOK / 128), 256, 0, stream>>>(bufA, w_in, nullptr, nullptr, proj, NIN, DM, DM, NIN, NIN);
    rope_k<<<(M_TOK * 80 + 255) / 256, 256, 0, stream>>>(proj);
    na_attn_k<<<M_TOK, 512, 0, stream>>>(proj, rpb, g_na, bufA);
    swa_attn_k<<<M_TOK, 512, 0, stream>>>(proj, sink, g_swa, bufA);
    gemm_k<1><<<dim3(DM / 128, M_TOK / 128), 256, 0, stream>>>(bufA, w_out, nullptr, x, x1, DM, DM, DM, DM, DM);
    rmsnorm1024_k<<<M_TOK, 256, 0, stream>>>(x1, g_ffn, bufA);
    constexpr int CH = 4096;
    for (int c0 = 0; c0 < M_TOK; c0 += CH) {
        gemm_k<2><<<dim3(DFF / 128, CH / 128), 256, 0, stream>>>(bufA + (size_t)c0 * DM, w_gate, w_up, nullptr, act, DFF, DM, DM, DFF, DFF);
        gemm_k<1><<<dim3(DM / 128, CH / 128), 256, 0, stream>>>(act, w_down, nullptr, x1 + (size_t)c0 * DM, out + (size_t)c0 * DM, DM, DFF, DFF, DM, DM);
    }
    rmsnorm1024_k<<<M_TOK, 256, 0, stream>>>(out, g_fin, out);
}
```

```cpp
#include <hip/hip_runtime.h>
#include <cstdio>
#include <cstdint>
namespace pg8 {
#define PG8_LAS __attribute__((address_space(3)))
typedef unsigned short bf16_t;
typedef short bf16x8 __attribute__((ext_vector_type(8)));
typedef float f32x4 __attribute__((ext_vector_type(4)));
typedef unsigned u32x4 __attribute__((ext_vector_type(4)));
constexpr int BM = 256, BK = 64, HALF = 128, HTB = HALF * BK * 2  , STAGE_BYTES = 8 * HTB, NXCD = 8, WGM = 8;

__host__ __device__ __forceinline__ int lds_byte(int r, int c) { const int st = (r >> 4) * 2 + (c >> 5), rr = r & 15, cc = c & 31, ob = rr * 64 + cc * 2; return st * 1024 + (ob ^ (((ob >> 9) & 1) << 5)); }
__host__ __device__ __forceinline__ void stage_rc(int b, int& R, int& C) { const int st = b / 1024, sb = b % 1024, swz = sb ^ (((sb >> 9) & 1) << 5); R = (st >> 1) * 16 + swz / 64; C = (st & 1) * 32 + (swz % 64) / 2; }
__host__ __device__ __forceinline__ int perm32(int rho) { const int n = rho >> 4, i = rho & 15; return 8 * (i >> 2) + 4 * n + (i & 3); }

__device__ __forceinline__ void st16_wt(void* p, u32x4 v) { asm volatile("global_store_dwordx4 %0, %1, off sc1\n\ts_nop 1" :: "v"(p), "v"(v) : "memory"); }
__device__ __forceinline__ void st8_wt(void* p, unsigned lo, unsigned hi) { typedef unsigned u32x2_ __attribute__((ext_vector_type(2))); const u32x2_ v = {lo, hi}; asm volatile("global_store_dwordx2 %0, %1, off sc1\n\ts_nop 1" :: "v"(p), "v"(v) : "memory"); }
__device__ __forceinline__ void st4_wt(void* p, float v) { asm volatile("global_store_dword %0, %1, off sc1\n\ts_nop 1" :: "v"(p), "v"(v) : "memory"); }
struct Unit { int pm, pn; };
struct Gemm { const bf16_t* A; const bf16_t* Bt; int M, N, K; int ablk = 0; };
__host__ __device__ __forceinline__ size_t hblk(int row, int col, int ld) { return ((size_t)(row >> 3) * (ld >> 5) + (col >> 5)) * 256 + (row & 7) * 32 + (col & 31); }

struct StaticOrder {
    int nM, nN, nwg, G, c;
    __host__ __device__ void init(int M, int N, int G_, int c_) { nM = M / BM; nN = N / BM; nwg = nM * nN; G = G_; c = c_; }
    __host__ __device__ bool next(int i, Unit& u) const {
        const long L = (long)i * G + c; if (L >= nwg) return false;
        int wgid = (int)L; { const int q = nwg / NXCD, r = nwg % NXCD, xcd = wgid % NXCD, off = wgid / NXCD; wgid = (xcd < r ? xcd * (q + 1) : r * (q + 1) + (xcd - r) * q) + off; }
        const int nig = WGM * nN, gid = wgid / nig, fm = gid * WGM, gsz = (nM - fm) < WGM ? (nM - fm) : WGM;
        u.pm = fm + ((wgid % nig) % gsz); u.pn = (wgid % nig) / gsz; return true;
    }
    __device__ __forceinline__ void a_ready(const Unit&) const {}
    __device__ __forceinline__ void done(const Unit&) const {}
};
struct RoundOrder : StaticOrder {
    int r0, r1;
    __host__ __device__ bool next(int i, Unit& u) const { if (r0 + i >= r1) return false; return StaticOrder::next(r0 + i, u); }
};
struct OneUnit {
    int pm;
    __host__ __device__ bool next(int i, Unit& u) const { if (i > 0) return false; u.pm = pm; u.pn = 0; return true; }
    __device__ __forceinline__ void a_ready(const Unit&) const {}
    __device__ __forceinline__ void done(const Unit&) const {}
};
__device__ __forceinline__ unsigned cvt_pk_bf16(float lo, float hi) { unsigned r; asm volatile("v_cvt_pk_bf16_f32 %0, %1, %2" : "=v"(r) : "v"(lo), "v"(hi)); return r; }
typedef float f32x2 __attribute__((ext_vector_type(2)));
typedef unsigned u32x2 __attribute__((ext_vector_type(2)));

__device__ __forceinline__ float rowsum4(float s) {
    auto r = __builtin_amdgcn_permlane16_swap(__float_as_uint(s), __float_as_uint(s), false, false); s = __uint_as_float(r[0]) + __uint_as_float(r[1]);
    auto t = __builtin_amdgcn_permlane32_swap(__float_as_uint(s), __float_as_uint(s), false, false); return __uint_as_float(t[0]) + __uint_as_float(t[1]); }
constexpr float QSCALE = 0.125f * 1.4426950408889634f;
constexpr float RMS_EPS = 1e-6f;
constexpr int SS_PITCH = 16384;

template <bool WT  > struct EpiQKV {
    static constexpr bool PERM = true, AFTER_DRAIN = false, RESID_LDS = false, BREMAP = true;
    bf16_t* O; int ldc; const PG8_LAS float* cs;
    __device__ __forceinline__ void operator()(const f32x4 (&acc)[2][2][4][2], const Unit& u, int wr, int wc, int fr, int fq) const {
        const int row0 = u.pm * BM + wr * 64 + fr, colw = u.pn * BM + wc * 64 + 8 * fq;
        const bool isq = (u.pn < 2) || (u.pn == 6) || (u.pn == 7);
        const float sc = isq ? QSCALE : 1.0f;
        const bool rope_tile = (u.pn >= 6);
        const bool lo = fr < 8;
        float rsv[2][4];
#pragma unroll
        for (int ai = 0; ai < 2; ++ai)
#pragma unroll
            for (int m = 0; m < 4; ++m) rsv[ai][m] = cs[256 * 16 + wr * 64 + fr + ai * HALF + m * 16];
#pragma unroll
        for (int ai = 0; ai < 2; ++ai)
#pragma unroll
            for (int m = 0; m < 4; ++m) {
                const int row = row0 + ai * HALF + m * 16;
                const float rsd = rsv[ai][m];
                f32x4 c0 = {1.f, 1.f, 1.f, 1.f}, c1 = c0, s0 = {0.f, 0.f, 0.f, 0.f}, s1 = s0;
                if (rope_tile && fq < 2) { const PG8_LAS float* t = cs + (row - u.pm * BM) * 16; c0 = *(const PG8_LAS f32x4*)t; c1 = *(const PG8_LAS f32x4*)(t + 4); s0 = *(const PG8_LAS f32x4*)(t + 8); s1 = *(const PG8_LAS f32x4*)(t + 12);
                    if (fq == 0) { s0 = -s0; s1 = -s1; } }
                u32x4 w[2];
#pragma unroll
                for (int bj = 0; bj < 2; ++bj) {
                    f32x4 v0 = acc[ai][bj][m][0] * (sc * rsd), v1 = acc[ai][bj][m][1] * (sc * rsd);
                    if (rope_tile && bj == 0) {
                        f32x4 p0, p1;
#pragma unroll
                        for (int e = 0; e < 4; ++e) { p0[e] = __shfl_xor(v0[e], 16); p1[e] = __shfl_xor(v1[e], 16); }
                        v0 = v0 * c0 + p0 * s0; v1 = v1 * c1 + p1 * s1;
                    }
                    w[bj].x = cvt_pk_bf16(v0[0], v0[1]); w[bj].y = cvt_pk_bf16(v0[2], v0[3]); w[bj].z = cvt_pk_bf16(v1[0], v1[1]); w[bj].w = cvt_pk_bf16(v1[2], v1[3]);
                }
                const u32x4 snd = lo ? w[1] : w[0]; u32x4 rcv;
#pragma unroll
                for (int e = 0; e < 4; ++e) { unsigned x = snd[e], y; asm volatile("s_nop 1\n\tv_mov_b32_dpp %0, %1 row_ror:8 row_mask:0xf bank_mask:0xf\n\ts_nop 0" : "=v"(y) : "v"(x)); rcv[e] = y; }
                bf16_t* pa = O + (size_t)(row - (lo ? 0 : 8)) * ldc + colw + (lo ? 0 : 32);
                if (WT) { st16_wt(pa, lo ? w[0] : rcv); st16_wt(pa + (size_t)8 * ldc, lo ? rcv : w[1]); } else { *(u32x4*)pa = lo ? w[0] : rcv; *(u32x4*)(pa + (size_t)8 * ldc) = lo ? rcv : w[1]; }
            }
    }
};

struct EpiKVHalf {
    static constexpr bool PERM = true, AFTER_DRAIN = false, RESID_LDS = false, BREMAP = false;
    bf16_t* O; int ldc; const PG8_LAS float* cs; int colbase; bool rope;
    __device__ __forceinline__ void operator()(const f32x4 (&acc)[2][2][4][2], const Unit& u, int wr, int wc, int fr, int fq) const {
        const int row0 = u.pm * BM + wr * 64 + fr, col0 = colbase + wc * 32 + 8 * fq;
        const bool rope_wave = rope && ((wc & 1) == 0);
        float rsv[2][4];
#pragma unroll
        for (int ai = 0; ai < 2; ++ai)
#pragma unroll
            for (int m = 0; m < 4; ++m) rsv[ai][m] = cs[256 * 16 + wr * 64 + fr + ai * HALF + m * 16];
#pragma unroll
        for (int ai = 0; ai < 2; ++ai)
#pragma unroll
            for (int m = 0; m < 4; ++m) {
                const int row = row0 + ai * HALF + m * 16;
                const float rsd = rsv[ai][m];
                f32x4 c0 = {1.f, 1.f, 1.f, 1.f}, c1 = c0, s0 = {0.f, 0.f, 0.f, 0.f}, s1 = s0;
                if (rope_wave && fq < 2) { const PG8_LAS float* t = cs + (row - u.pm * BM) * 16; c0 = *(const PG8_LAS f32x4*)t; c1 = *(const PG8_LAS f32x4*)(t + 4); s0 = *(const PG8_LAS f32x4*)(t + 8); s1 = *(const PG8_LAS f32x4*)(t + 12);
                    if (fq == 0) { s0 = -s0; s1 = -s1; } }
                f32x4 v0 = acc[ai][0][m][0] * rsd, v1 = acc[ai][0][m][1] * rsd;
                if (rope_wave) {
                    f32x4 p0, p1;
#pragma unroll
                    for (int e = 0; e < 4; ++e) { p0[e] = __shfl_xor(v0[e], 16); p1[e] = __shfl_xor(v1[e], 16); }
                    v0 = v0 * c0 + p0 * s0; v1 = v1 * c1 + p1 * s1;
                }
                u32x4 w; w.x = cvt_pk_bf16(v0[0], v0[1]); w.y = cvt_pk_bf16(v0[2], v0[3]); w.z = cvt_pk_bf16(v1[0], v1[1]); w.w = cvt_pk_bf16(v1[2], v1[3]);
                st16_wt(O + (size_t)row * ldc + col0, w);
            }
    }
};

struct EpiOutProj {
    static constexpr bool PERM = false, AFTER_DRAIN = true, RESID_LDS = true, BREMAP = true;
    bf16_t* xn; float* ss; int ldc;
    const bf16_t* rbase; int rld;
    __device__ __forceinline__ void fused(f32x4 (&acc)[2][2][4][2], const Unit& u, int wr, int wc, int fr, int fq, PG8_LAS unsigned char* lds, int wid, int lane) const {
        const int row0 = u.pm * BM + wr * 64 + fr;
        const int bo = ((4 * wr) * 2) * 1024 + ((fr * 64 + fq * 8) ^ ((fr >> 3) << 5));
        const bool odd = (fq & 1) != 0, lo = fr < 8;
        const int c8 = (odd ? 16 : 0) + 8 * (fq >> 1);
#pragma unroll
        for (int ai = 0; ai < 2; ++ai) {
            const int so = wc == 0 ? (4 + ai) * HTB : wc == 1 ? ai * HTB : wc == 2 ? (6 + ai) * HTB : (ai ? 131072 + 4096 : 2 * HTB);
            u32x2 xr[4][2][2];
#pragma unroll
            for (int m = 0; m < 4; ++m)
#pragma unroll
                for (int bj = 0; bj < 2; ++bj) { const int lo_ = bo + 2048 * m + 1024 * bj; xr[m][bj][0] = *(const PG8_LAS u32x2*)(lds + so + lo_); xr[m][bj][1] = *(const PG8_LAS u32x2*)(lds + so + (lo_ ^ 32)); }
#pragma unroll
            for (int m = 0; m < 4; ++m) {
                const int row = row0 + ai * HALF + m * 16; float s = 0.f;
                u32x4 w[2];
#pragma unroll
                for (int bj = 0; bj < 2; ++bj) {
                    const u32x2 x0 = xr[m][bj][0], x1 = xr[m][bj][1];
                    const f32x4 v0 = acc[ai][bj][m][0] + (f32x4){__uint_as_float(x0.x << 16), __uint_as_float(x0.x & 0xffff0000u), __uint_as_float(x0.y << 16), __uint_as_float(x0.y & 0xffff0000u)};
                    const f32x4 v1 = acc[ai][bj][m][1] + (f32x4){__uint_as_float(x1.x << 16), __uint_as_float(x1.x & 0xffff0000u), __uint_as_float(x1.y << 16), __uint_as_float(x1.y & 0xffff0000u)};
                    s += ((v0[0] * v0[0] + v0[1] * v0[1]) + (v0[2] * v0[2] + v0[3] * v0[3])) + ((v1[0] * v1[0] + v1[1] * v1[1]) + (v1[2] * v1[2] + v1[3] * v1[3]));
                    const unsigned a0 = cvt_pk_bf16(v0[0], v0[1]), a1 = cvt_pk_bf16(v0[2], v0[3]), b0 = cvt_pk_bf16(v1[0], v1[1]), b1 = cvt_pk_bf16(v1[2], v1[3]);
                    const auto sw0 = __builtin_amdgcn_permlane16_swap(a0, b0, false, false), sw1 = __builtin_amdgcn_permlane16_swap(a1, b1, false, false);
                    w[bj].x = sw0[0]; w[bj].y = sw1[0]; w[bj].z = sw0[1]; w[bj].w = sw1[1];
                }
                const u32x4 snd = lo ? w[1] : w[0]; u32x4 rcv;
#pragma unroll
                for (int e = 0; e < 4; ++e) { unsigned x = snd[e], y; asm volatile("s_nop 1\n\tv_mov_b32_dpp %0, %1 row_ror:8 row_mask:0xf bank_mask:0xf\n\ts_nop 0" : "=v"(y) : "v"(x)); rcv[e] = y; }
                bf16_t* pa = xn + (size_t)(row - (lo ? 0 : 8)) * ldc + u.pn * BM + wc * 64 + (lo ? 0 : 32) + c8;
                st16_wt(pa, lo ? w[0] : rcv); st16_wt(pa + (size_t)8 * ldc, lo ? rcv : w[1]);
                s = rowsum4(s);
                if (fq == 0) st4_wt(ss + (size_t)(u.pn * 4 + wc) * SS_PITCH + row, s);
            }
        }
    }
};

struct EpiSwiGLU {
    static constexpr bool PERM = true, AFTER_DRAIN = false, RESID_LDS = false, BREMAP = false;
    bf16_t* H; int ldc; const PG8_LAS f32x2* rs;
    __device__ __forceinline__ void operator()(const f32x4 (&acc)[2][2][4][2], const Unit& u, int wr, int wc, int fr, int fq) const {
        const int rl0 = wr * 64 + fr, row0 = u.pm * BM + rl0, col0 = u.pn * HALF + wc * 32 + 8 * fq;
        f32x2 cc[2][4];
#pragma unroll
        for (int ai = 0; ai < 2; ++ai)
#pragma unroll
            for (int m = 0; m < 4; ++m) cc[ai][m] = rs[rl0 + ai * HALF + m * 16];
#pragma unroll
        for (int ai = 0; ai < 2; ++ai)
#pragma unroll
            for (int m = 0; m < 4; ++m) {
                const f32x2 c = cc[ai][m];
                float hv[8];
#pragma unroll
                for (int n = 0; n < 2; ++n) {
                    const f32x4 ag = acc[ai][0][m][n], au = acc[ai][1][m][n];
                    const f32x4 t = ag * c.x, p = t * au;
#pragma unroll
                    for (int e = 0; e < 4; ++e) hv[n * 4 + e] = p[e] * __builtin_amdgcn_rcpf(__builtin_fmaf(__builtin_amdgcn_exp2f(t[e]), c.y, c.y));
                }
                u32x4 w; w.x = cvt_pk_bf16(hv[0], hv[1]); w.y = cvt_pk_bf16(hv[2], hv[3]); w.z = cvt_pk_bf16(hv[4], hv[5]); w.w = cvt_pk_bf16(hv[6], hv[7]);
                st16_wt(H + hblk(row0 + ai * HALF + m * 16, col0, ldc), w);
            }
    }
};

struct EpiSwiGLUHalf {
    static constexpr bool PERM = true, AFTER_DRAIN = false, RESID_LDS = false, BREMAP = false;
    bf16_t* H; int ldc; const PG8_LAS f32x2* rs; int colbase;
    __device__ __forceinline__ void operator()(const f32x4 (&acc)[2][2][4][2], const Unit& u, int wr, int wc, int fr, int fq) const {
        const int rl0 = wr * 64 + fr, row0 = u.pm * BM + rl0, col0 = colbase + wc * 16 + 4 * fq;
        f32x2 cc[2][4];
#pragma unroll
        for (int ai = 0; ai < 2; ++ai)
#pragma unroll
            for (int m = 0; m < 4; ++m) cc[ai][m] = rs[rl0 + ai * HALF + m * 16];
#pragma unroll
        for (int ai = 0; ai < 2; ++ai)
#pragma unroll
            for (int m = 0; m < 4; ++m) {
                const f32x2 c = cc[ai][m];
                const f32x4 ag = acc[ai][0][m][0], au = acc[ai][0][m][1];
                const f32x4 t = ag * c.x, p = t * au;
                float hv[4];
#pragma unroll
                for (int e = 0; e < 4; ++e) hv[e] = p[e] * __builtin_amdgcn_rcpf(__builtin_fmaf(__builtin_amdgcn_exp2f(t[e]), c.y, c.y));
                st8_wt(H + hblk(row0 + ai * HALF + m * 16, col0, ldc), cvt_pk_bf16(hv[0], hv[1]), cvt_pk_bf16(hv[2], hv[3]));
            }
    }
};

struct RmsStats {
    unsigned* xbuf;
    unsigned* cnt;
    unsigned* tmo;
    unsigned code;
    __device__ __forceinline__ bool run(const f32x4 (&v)[2][2][4][2], const Unit& u, int wr, int wc, int fr, int fq, PG8_LAS unsigned char* lds, int wid, int lane) const {
        PG8_LAS float* P = (PG8_LAS float*)lds;
        PG8_LAS float* S = (PG8_LAS float*)(lds + 4096);
        PG8_LAS unsigned* flag = (PG8_LAS unsigned*)(lds + 4096 + 1024);
        if (wid == 0 && lane == 0) flag[0] = 0u;
#pragma unroll
        for (int ai = 0; ai < 2; ++ai)
#pragma unroll
            for (int m = 0; m < 4; ++m) {
                float s = 0.f;
#pragma unroll
                for (int bj = 0; bj < 2; ++bj)
#pragma unroll
                    for (int n = 0; n < 2; ++n) { const f32x4 x = v[ai][bj][m][n]; s += (x[0] * x[0] + x[1] * x[1]) + (x[2] * x[2] + x[3] * x[3]); }
                s = rowsum4(s);
                if (fq == 0) P[(ai * HALF + wr * 64 + m * 16 + fr) * 4 + wc] = s;
            }
        asm volatile("s_waitcnt lgkmcnt(0)" ::: "memory"); __builtin_amdgcn_s_barrier(); asm volatile("" ::: "memory");
        const int row = wid * 32 + (lane & 31);
        bool dead = false;
        if (lane < 32) {
            const float tot = (P[row * 4 + 0] + P[row * 4 + 1]) + (P[row * 4 + 2] + P[row * 4 + 3]);
            unsigned long long* slots = (unsigned long long*)xbuf + (size_t)(u.pm * BM + row) * 4;
            st8_wt(slots + u.pn, __float_as_uint(tot), 1u);
            float q = tot;
#pragma unroll
            for (int t = 1; t < 4; ++t) {
                const int o = (u.pn + t) & 3; unsigned long long v; unsigned sp = 0;
                for (;;) { v = __hip_atomic_load(slots + o, __ATOMIC_RELAXED, __HIP_MEMORY_SCOPE_AGENT); if ((unsigned)(v >> 32) == 1u) break; if (++sp > (1u << 20)) { dead = true; break; } __builtin_amdgcn_s_sleep(1); }
                q += __uint_as_float((unsigned)v);
            }
            S[row] = 1.0f / sqrtf(q * (1.0f / 1024.0f) + RMS_EPS);
        }
        if (__any(dead)) { if (lane == 0) { unsigned expect = 0u; __hip_atomic_compare_exchange_strong(tmo + 1, &expect, code | (unsigned)(u.pm & 0xff), __ATOMIC_RELAXED, __ATOMIC_RELAXED, __HIP_MEMORY_SCOPE_AGENT);
                                            __hip_atomic_store(tmo, 1u, __ATOMIC_RELAXED, __HIP_MEMORY_SCOPE_AGENT); flag[0] = 1u; } }
        asm volatile("s_waitcnt vmcnt(0) lgkmcnt(0)" ::: "memory"); __builtin_amdgcn_s_barrier(); asm volatile("" ::: "memory");
        const bool bad = flag[0] != 0u;
        return bad;
    }
};
struct EpiDownFinal {
    static constexpr bool PERM = false, AFTER_DRAIN = true, RESID_LDS = true, BREMAP = false;
    const bf16_t* rbase; int rld; float* out; int ldc; const float* g; RmsStats st; unsigned poison; const unsigned* diag;
    __device__ __forceinline__ void fused(f32x4 (&acc)[2][2][4][2], const Unit& u, int wr, int wc, int fr, int fq, PG8_LAS unsigned char* lds, int wid, int lane) const {
        const PG8_LAS float* S = (const PG8_LAS float*)(lds + 4096);
        const int col0 = u.pn * BM + wc * 32 + 4 * fq;
        {   const int w2 = wc >> 1;
            const int bo = ((4 * wr) * 2 + (wc & 1)) * 1024 + ((fr * 64 + fq * 8) ^ ((fr >> 3) << 5));
#pragma unroll
            for (int ai = 0; ai < 2; ++ai)
#pragma unroll
                for (int bj = 0; bj < 2; ++bj) {
                    const int so = bj == 0 ? (w2 ? ai * HTB : (4 + ai) * HTB) : (w2 ? (ai ? 131072 + 4096 : 2 * HTB) : (6 + ai) * HTB);
#pragma unroll
                    for (int m = 0; m < 4; ++m)
#pragma unroll
                        for (int n = 0; n < 2; ++n) { const u32x2 w = *(const PG8_LAS u32x2*)(lds + so + ((bo + 2048 * m) ^ (32 * n)));
                            acc[ai][bj][m][n] += (f32x4){__uint_as_float(w.x << 16), __uint_as_float(w.x & 0xffff0000u), __uint_as_float(w.y << 16), __uint_as_float(w.y & 0xffff0000u)}; }
                }
            asm volatile("s_waitcnt lgkmcnt(0)" ::: "memory"); __builtin_amdgcn_s_barrier(); asm volatile("" ::: "memory");
        }
        f32x4 gv[2][2];
#pragma unroll
        for (int bj = 0; bj < 2; ++bj)
#pragma unroll
            for (int n = 0; n < 2; ++n) gv[bj][n] = *(const f32x4*)(g + col0 + bj * HALF + n * 16);
        const bool bad = st.run(acc, u, wr, wc, fr, fq, lds, wid, lane) || poison != 0u;
        const float qnan = __builtin_nanf("");
        const bool lo = fr < 8;
#pragma unroll
        for (int ai = 0; ai < 2; ++ai)
#pragma unroll
            for (int m = 0; m < 4; ++m) { const int r = ai * HALF + wr * 64 + m * 16 + fr; const float sr = S[r];
                const size_t offA = (size_t)(u.pm * BM + r - (lo ? 0 : 8)) * ldc + col0 + (lo ? 0 : 16), offB = offA + (size_t)8 * ldc;
#pragma unroll
                for (int bj = 0; bj < 2; ++bj) {
                    f32x4 o0 = acc[ai][bj][m][0] * sr * gv[bj][0], o1 = acc[ai][bj][m][1] * sr * gv[bj][1];
                    if (bad) { o0 = (f32x4){qnan, qnan, qnan, qnan}; o1 = o0; }
                    const f32x4 snd = lo ? o1 : o0; f32x4 rcv;
#pragma unroll
                    for (int e = 0; e < 4; ++e) { float x = snd[e], y; asm volatile("s_nop 1\n\tv_mov_b32_dpp %0, %1 row_ror:8 row_mask:0xf bank_mask:0xf\n\ts_nop 0" : "=v"(y) : "v"(x)); rcv[e] = y; }
                    const f32x4 sa = lo ? o0 : rcv, sb = lo ? rcv : o1;
                    __builtin_nontemporal_store(sa, (f32x4*)(out + offA + bj * HALF)); __builtin_nontemporal_store(sb, (f32x4*)(out + offB + bj * HALF)); } }
    }
};

template <class Epi, class Sched, bool ALIGN_EPI = false, bool SP2 = false, bool HN = false>
__device__ __forceinline__ void gemm_phase(PG8_LAS unsigned char* lds, const Gemm g, const Sched& S, const Epi& E, const char* tailB = nullptr, bool pre_staged = false) {
    int tid_ = threadIdx.x; asm volatile("" : "+v"(tid_));
    const int tid = tid_, wid = __builtin_amdgcn_readfirstlane(tid >> 6), lane = tid & 63, wr = wid >> 2, wc = wid & 3, fr = lane & 15, fq = lane >> 4;
    const int K = g.K, nt = K / BK;
    unsigned voffA[2], voffB[2];
#pragma unroll
    for (int i = 0; i < 2; ++i) { int R, C; stage_rc(tid * 16 + i * 8192, R, C); const int Rm = Epi::BREMAP ? 64 * (R >> 5) + (R & 31) : R; const int Rb = Epi::PERM ? ((Rm & ~31) + perm32(Rm & 31)) : Rm;
        voffA[i] = g.ablk ? (unsigned)hblk(R, C, K) * 2u : (unsigned)(R * K + C) * 2u; voffB[i] = (unsigned)(Rb * K + C) * 2u; }
    constexpr bool RL = Epi::RESID_LDS;
    constexpr int X9OFF = 131072 + 4096;
    unsigned voffR[2] = {0u, 0u};
    if constexpr (RL) {
#pragma unroll
        for (int i = 0; i < 2; ++i) { int R, C; stage_rc(tid * 16 + i * 8192, R, C); voffR[i] = (unsigned)(R * E.rld + C) * 2u; }
    }
    const size_t kstep = (size_t)(BK * 2);
    const size_t kstepA = g.ablk ? (size_t)1024 : kstep;
    const size_t hstep = (size_t)HALF * K * 2;
    const size_t tstep = 2 * hstep;
    const size_t bhs = Epi::BREMAP ? (size_t)32 * K * 2 : hstep;
    const unsigned ldsw = (unsigned)wid * 1024u;
    const int aoff = lds_byte(wr * 64 + fr, fq * 8), boff = lds_byte(wc * 32 + fr, fq * 8);
#define PG8_SA(b, h) (((b) * 2 + (h)) * HTB)
#define PG8_SB(b, h) ((4 + (b) * 2 + (h)) * HTB)
#define PG8_STAGE(bufoff, gbase, voff) do { _Pragma("unroll") for (int _i = 0; _i < 2; ++_i) \
        __builtin_amdgcn_global_load_lds((const unsigned*)((const char*)(gbase) + (voff)[_i]), (PG8_LAS unsigned*)(lds + (bufoff) + ldsw + _i * 8192), 16, 0, 0); } while (0)
#define PG8_LDA(dst, b, h) do { _Pragma("unroll") for (int m = 0; m < 4; ++m) _Pragma("unroll") for (int k = 0; k < 2; ++k) dst[m][k] = *(const PG8_LAS bf16x8*)(lds + PG8_SA(b, h) + aoff + m * 2048 + k * 1024); } while (0)
#define PG8_LDB(dst, b, h) do { _Pragma("unroll") for (int n = 0; n < 2; ++n) _Pragma("unroll") for (int k = 0; k < 2; ++k) dst[n][k] = *(const PG8_LAS bf16x8*)(lds + PG8_SB(b, h) + boff + n * 2048 + k * 1024); } while (0)
#define PG8_MMA(ai, bj, At, Bt) do { __builtin_amdgcn_s_setprio(1); _Pragma("unroll") for (int m = 0; m < 4; ++m) _Pragma("unroll") for (int n = 0; n < 2; ++n) _Pragma("unroll") for (int k = 0; k < 2; ++k) \
        acc[ai][bj][m][n] = __builtin_amdgcn_mfma_f32_16x16x32_bf16(Bt[n][k], At[m][k], acc[ai][bj][m][n], 0, 0, 0); __builtin_amdgcn_s_setprio(0); } while (0)
#define PG8_WAIT_V(n) asm volatile("s_waitcnt vmcnt(" #n ")" ::: "memory")
#define PG8_WAIT_L(n) asm volatile("s_waitcnt lgkmcnt(" #n ")" ::: "memory")
#define PG8_BAR __builtin_amdgcn_s_barrier()
#define PG8_SCHED __builtin_amdgcn_sched_barrier(0)
    Unit cur, nxt; int ui = 0;
    if (!S.next(0, cur)) return;
    f32x4 acc[2][2][4][2];
#pragma unroll
    for (int a = 0; a < 2; ++a)
#pragma unroll
        for (int b = 0; b < 2; ++b)
#pragma unroll
            for (int m = 0; m < 4; ++m)
#pragma unroll
                for (int n = 0; n < 2; ++n) acc[a][b][m][n] = (f32x4){0.f, 0.f, 0.f, 0.f};
    bf16x8 At[4][2], B0[2][2], B1[2][2];
    const char* cA = (const char*)g.A + (size_t)cur.pm * tstep; const char* cB = (const char*)g.Bt + (size_t)cur.pn * tstep;
    S.a_ready(cur);
    static_assert(!HN || SP2, "HN is implemented for the SP2 loop only");
    if constexpr (SP2 && HN) {
        if (!pre_staged) { PG8_STAGE(PG8_SB(0, 0), cB, voffB); PG8_STAGE(PG8_SA(0, 0), cA, voffA); PG8_STAGE(PG8_SA(0, 1), cA + hstep, voffA); }
        if (wr == 1) PG8_BAR;
        PG8_WAIT_V(2); PG8_BAR;
        if (!pre_staged) { PG8_STAGE(PG8_SB(1, 0), cB + kstep, voffB); PG8_STAGE(PG8_SA(1, 0), cA + kstep, voffA); }
        PG8_WAIT_V(4); PG8_BAR;
    } else if constexpr (SP2) {
        PG8_STAGE(PG8_SB(0, 0), cB, voffB); PG8_STAGE(PG8_SB(0, 1), cB + bhs, voffB); PG8_STAGE(PG8_SA(0, 0), cA, voffA); PG8_STAGE(PG8_SA(0, 1), cA + hstep, voffA);
        if (wr == 1) PG8_BAR;
        PG8_WAIT_V(2); PG8_BAR;
        PG8_STAGE(PG8_SB(1, 0), cB + kstep, voffB); PG8_STAGE(PG8_SA(1, 0), cA + kstepA, voffA); PG8_STAGE(PG8_SB(1, 1), cB + bhs + kstep, voffB);
        PG8_WAIT_V(6); PG8_BAR;
    } else {
        PG8_STAGE(PG8_SB(0, 0), cB, voffB); PG8_STAGE(PG8_SA(0, 0), cA, voffA); PG8_STAGE(PG8_SB(0, 1), cB + hstep, voffB); PG8_STAGE(PG8_SA(0, 1), cA + hstep, voffA);
        if (wr == 1) PG8_BAR;
        PG8_WAIT_V(4); PG8_BAR;
        PG8_STAGE(PG8_SB(1, 0), cB + kstep, voffB); PG8_STAGE(PG8_SA(1, 0), cA + kstep, voffA); PG8_STAGE(PG8_SB(1, 1), cB + hstep + kstep, voffB);
        PG8_WAIT_V(6); PG8_BAR;
    }
    for (;;) {
        const bool has_next = S.next(ui + 1, nxt);
        const char* nA = has_next ? (const char*)g.A + (size_t)nxt.pm * tstep : cA; const char* nB = has_next ? (const char*)g.Bt + (size_t)nxt.pn * tstep : (tailB != nullptr ? tailB : cB);
        for (int t = 0; t < nt; t += 2) {
            const bool last = (t == nt - 2);
            const char* a1 = cA + (size_t)(t + 1) * kstepA;
            const char* a2 = last ? nA : cA + (size_t)(t + 2) * kstepA; const char* b2 = last ? nB : cB + (size_t)(t + 2) * kstep;
            const char* a3 = a2 + kstepA; const char* b3 = b2 + kstep;
            if (last && has_next) S.a_ready(nxt);
            if constexpr (SP2 && HN) {
            PG8_LDB(B0, 0, 0); PG8_SCHED; PG8_LDA(At, 0, 0); PG8_STAGE(PG8_SA(1, 1), a1 + hstep, voffA);
            PG8_WAIT_V(6); PG8_WAIT_L(0); PG8_BAR; PG8_MMA(0, 0, At, B0); PG8_BAR; PG8_SCHED;
            PG8_LDA(At, 0, 1); PG8_STAGE(PG8_SB(0, 0), b2, voffB); PG8_STAGE(PG8_SA(0, 0), a2, voffA);
            PG8_WAIT_V(6); PG8_WAIT_L(0); PG8_BAR; PG8_MMA(1, 0, At, B0); PG8_BAR; PG8_SCHED;
            PG8_LDB(B0, 1, 0); PG8_SCHED; PG8_LDA(At, 1, 0); PG8_STAGE(PG8_SA(0, 1), a2 + hstep, voffA);
            PG8_WAIT_V(6); PG8_WAIT_L(0); PG8_BAR; PG8_MMA(0, 0, At, B0); PG8_BAR; PG8_SCHED;
            PG8_LDA(At, 1, 1); PG8_STAGE(PG8_SB(1, 0), b3, voffB); PG8_STAGE(PG8_SA(1, 0), a3, voffA);
            PG8_WAIT_V(6); PG8_WAIT_L(0); PG8_BAR; PG8_MMA(1, 0, At, B0); PG8_BAR; PG8_SCHED;
            } else if constexpr (SP2) {
            const bool ll = RL && last && !has_next;
            const char* rb = nullptr; size_t rldb = 0;
            if constexpr (RL) { rldb = (size_t)E.rld * 2; rb = (const char*)E.rbase + ((size_t)cur.pm * BM * E.rld + (size_t)cur.pn * BM) * 2; }
#define PG8_RP(kt, h) (rb + (size_t)(h) * HALF * rldb + (kt) * 128)
            const unsigned vA_[2] = {ll ? voffR[0] : voffA[0], ll ? voffR[1] : voffA[1]}, vB_[2] = {ll ? voffR[0] : voffB[0], ll ? voffR[1] : voffB[1]};
            const char* q_b2 = ll ? PG8_RP(0, 0) : b2; const char* q_b2h = ll ? PG8_RP(0, 1) : b2 + bhs; const char* q_a2 = ll ? PG8_RP(1, 0) : a2; const char* q_a2h = ll ? PG8_RP(1, 1) : a2 + hstep;
            const char* q_b3 = ll ? PG8_RP(2, 0) : b3; const char* q_b3h = ll ? PG8_RP(2, 1) : b3 + bhs; const char* q_a3 = ll ? PG8_RP(3, 0) : a3;
            PG8_LDB(B0, 0, 0); PG8_LDB(B1, 0, 1); PG8_SCHED; PG8_LDA(At, 0, 0); PG8_STAGE(PG8_SA(1, 1), a1 + hstep, voffA);
            PG8_WAIT_V(8); PG8_WAIT_L(0); PG8_BAR; PG8_MMA(0, 0, At, B0); PG8_MMA(0, 1, At, B1); PG8_BAR; PG8_SCHED;
            PG8_LDA(At, 0, 1); PG8_STAGE(PG8_SB(0, 0), q_b2, vB_); PG8_STAGE(PG8_SB(0, 1), q_b2h, vB_); PG8_STAGE(PG8_SA(0, 0), q_a2, vA_);
            PG8_WAIT_V(8); PG8_WAIT_L(0); PG8_BAR; PG8_MMA(1, 0, At, B0); PG8_MMA(1, 1, At, B1); PG8_BAR; PG8_SCHED;
            PG8_LDB(B0, 1, 0); PG8_LDB(B1, 1, 1); PG8_SCHED; PG8_LDA(At, 1, 0); PG8_STAGE(PG8_SA(0, 1), q_a2h, vA_);
            if (ll) { PG8_STAGE(X9OFF, PG8_RP(3, 1), voffR); PG8_WAIT_V(10); } else PG8_WAIT_V(8);
            PG8_WAIT_L(0); PG8_BAR; PG8_MMA(0, 0, At, B0); PG8_MMA(0, 1, At, B1); PG8_BAR; PG8_SCHED;
            PG8_LDA(At, 1, 1); PG8_STAGE(PG8_SB(1, 0), q_b3, vB_); PG8_STAGE(PG8_SB(1, 1), q_b3h, vB_); PG8_STAGE(PG8_SA(1, 0), q_a3, vA_);
            if (ll) PG8_WAIT_V(10); else PG8_WAIT_V(8);
            PG8_WAIT_L(0); PG8_BAR; PG8_MMA(1, 0, At, B0); PG8_MMA(1, 1, At, B1); PG8_BAR; PG8_SCHED;
#undef PG8_RP
            } else {
            PG8_LDB(B0, 0, 0); PG8_SCHED; PG8_LDA(At, 0, 0); PG8_STAGE(PG8_SA(1, 1), a1 + hstep, voffA);
            PG8_WAIT_L(8); PG8_BAR; PG8_WAIT_L(0); PG8_MMA(0, 0, At, B0); PG8_BAR; PG8_SCHED;
            PG8_LDB(B1, 0, 1); PG8_STAGE(PG8_SB(0, 0), b2, voffB);
            PG8_BAR; PG8_WAIT_L(0); PG8_MMA(0, 1, At, B1); PG8_BAR;
            PG8_LDA(At, 0, 1); PG8_STAGE(PG8_SA(0, 0), a2, voffA);
            PG8_BAR; PG8_WAIT_L(0); PG8_MMA(1, 0, At, B0); PG8_BAR; PG8_SCHED;
            PG8_STAGE(PG8_SB(0, 1), b2 + hstep, voffB);
            PG8_WAIT_V(6); PG8_BAR; PG8_MMA(1, 1, At, B1); PG8_BAR;
            PG8_LDB(B0, 1, 0); PG8_SCHED; PG8_LDA(At, 1, 0); PG8_STAGE(PG8_SA(0, 1), a2 + hstep, voffA);
            PG8_WAIT_L(8); PG8_BAR; PG8_WAIT_L(0); PG8_MMA(0, 0, At, B0); PG8_BAR; PG8_SCHED;
            PG8_LDB(B1, 1, 1); PG8_STAGE(PG8_SB(1, 0), b3, voffB);
            PG8_BAR; PG8_WAIT_L(0); PG8_MMA(0, 1, At, B1); PG8_BAR;
            PG8_LDA(At, 1, 1); PG8_STAGE(PG8_SA(1, 0), a3, voffA);
            PG8_BAR; PG8_WAIT_L(0); PG8_MMA(1, 0, At, B0); PG8_BAR; PG8_SCHED;
            PG8_STAGE(PG8_SB(1, 1), b3 + hstep, voffB);
            PG8_WAIT_V(6); PG8_BAR; PG8_MMA(1, 1, At, B1); PG8_BAR;
            }
        }
        if constexpr (ALIGN_EPI) { if (wr == 0) PG8_BAR; }
        if constexpr (!Epi::AFTER_DRAIN) { E(acc, cur, wr, wc, fr, fq); S.done(cur); }
        if (!has_next) break;
#pragma unroll
        for (int a = 0; a < 2; ++a)
#pragma unroll
            for (int b = 0; b < 2; ++b)
#pragma unroll
                for (int m = 0; m < 4; ++m)
#pragma unroll
                    for (int n = 0; n < 2; ++n) acc[a][b][m][n] = (f32x4){0.f, 0.f, 0.f, 0.f};
        cur = nxt; cA = nA; cB = nB; ++ui;
        if constexpr (ALIGN_EPI) { if (wr == 1) PG8_BAR; }
    }
    PG8_WAIT_V(0);
    if constexpr (!ALIGN_EPI) { if (wr == 0) PG8_BAR; }
    PG8_BAR;
    if constexpr (Epi::AFTER_DRAIN) { E.fused(acc, cur, wr, wc, fr, fq, lds, wid, lane); S.done(cur); }
#undef PG8_SA
#undef PG8_SB
#undef PG8_STAGE
#undef PG8_LDA
#undef PG8_LDB
#undef PG8_MMA
#undef PG8_WAIT_V
#undef PG8_WAIT_L
#undef PG8_BAR
#undef PG8_SCHED
}
}

#ifndef PG8_SP2
#define PG8_SP2 true
#endif
#ifndef PG8_ALIGN
#define PG8_ALIGN true
#endif

namespace att {
typedef short bf16x8 __attribute__((ext_vector_type(8)));
typedef short s16x4 __attribute__((ext_vector_type(4)));
typedef float f32x16 __attribute__((ext_vector_type(16)));
typedef float f32x4 __attribute__((ext_vector_type(4)));
typedef unsigned u32x4 __attribute__((ext_vector_type(4)));
#define ATT_LAS __attribute__((address_space(3)))
constexpr int SEQ = 2048, NIN = 2304, DOUT = 1024;
constexpr float LOG2E = 1.4426950408889634f, THR = 8.0f, RMS_EPS = 1e-6f;
constexpr int WAVE_RING = 16384;
constexpr int SH_SLOT = 16384;
constexpr int LDS_SCR = 131072 + 512;
constexpr int LDS_BIAS = 131072 + 4096 + 512;
constexpr int NBIAS = 8 * 15 * 31;
constexpr int LDS_GTAB = LDS_BIAS + NBIAS * 4 + 512;
constexpr int LDS_END = LDS_GTAB + 4096;
constexpr int TPITCH = 1040;

__device__ __forceinline__ unsigned cvtpk(float lo, float hi) { typedef float f2 __attribute__((ext_vector_type(2))); typedef __bf16 b2 __attribute__((ext_vector_type(2))); f2 v = {lo, hi}; b2 b = __builtin_convertvector(v, b2); return __builtin_bit_cast(unsigned, b); }
__device__ __forceinline__ float swapmax(float m) { auto rr = __builtin_amdgcn_permlane32_swap(__float_as_uint(m), __float_as_uint(m), false, false); return fmaxf(__uint_as_float(rr[0]), __uint_as_float(rr[1])); }
__device__ __forceinline__ float swapsum(float m) { auto rr = __builtin_amdgcn_permlane32_swap(__float_as_uint(m), __float_as_uint(m), false, false); return __uint_as_float(rr[0]) + __uint_as_float(rr[1]); }
__device__ __forceinline__ s16x4 vtr(const ATT_LAS unsigned char* p) { typedef short v4i16_t __attribute__((ext_vector_type(4))); return __builtin_bit_cast(s16x4, __builtin_amdgcn_ds_read_tr16_b64_v4i16((ATT_LAS v4i16_t*)p)); }
#define ATT_OFF(reg) (((reg) & 3) + 8 * ((reg) >> 2))
__device__ __forceinline__ float max3f(float a, float b, float c) { float r; asm("v_max3_f32 %0, %1, %2, %3" : "=v"(r) : "v"(a), "v"(b), "v"(c)); return r; }
__device__ __forceinline__ float max16(const f32x16& p) { float a = max3f(p[0], p[1], p[2]), b = max3f(p[3], p[4], p[5]); a = max3f(a, p[6], p[7]); b = max3f(b, p[8], p[9]); a = max3f(a, p[10], p[11]); b = max3f(b, p[12], p[13]); a = max3f(a, p[14], p[15]); return max3f(a, b, b); }
__device__ __forceinline__ float max2f(float a, float b) { float r; asm("v_max_f32_e32 %0, %1, %2" : "=v"(r) : "v"(a), "v"(b)); return r; }
__device__ __forceinline__ float swapmax_nc(float m) { auto rr = __builtin_amdgcn_permlane32_swap(__float_as_uint(m), __float_as_uint(m), false, false); return max2f(__uint_as_float(rr[0]), __uint_as_float(rr[1])); }
__device__ __forceinline__ void glds16(const void* gsrc, unsigned lds_dst) { unsigned keep;
    asm volatile("s_mov_b32 %0, m0\n\ts_mov_b32 m0, %2\n\ts_nop 0\n\tglobal_load_lds_dwordx4 %1, off\n\ts_mov_b32 m0, %0" : "=&s"(keep) : "v"(gsrc), "s"(lds_dst) : "memory"); }
__device__ __forceinline__ void glds_na_block(unsigned vk0, unsigned vk1, unsigned vv, const void* b0, const void* b1, const void* b2, const void* b3, unsigned kdst) { unsigned keep;
    asm volatile("s_mov_b32 %0, m0\n\ts_mov_b32 m0, %8\n\ts_nop 0\n\tglobal_load_lds_dwordx4 %1, %4\n\t"
                 "s_add_u32 m0, m0, 0x400\n\ts_nop 0\n\tglobal_load_lds_dwordx4 %2, %5\n\t"
                 "s_add_u32 m0, m0, 0x400\n\ts_nop 0\n\tglobal_load_lds_dwordx4 %1, %6\n\t"
                 "s_add_u32 m0, m0, 0x400\n\ts_nop 0\n\tglobal_load_lds_dwordx4 %2, %7\n\t"
                 "s_add_u32 m0, m0, 0x1400\n\ts_nop 0\n\tglobal_load_lds_dwordx4 %3, %4\n\t"
                 "s_add_u32 m0, m0, 0x400\n\ts_nop 0\n\tglobal_load_lds_dwordx4 %3, %5\n\t"
                 "s_add_u32 m0, m0, 0x400\n\ts_nop 0\n\tglobal_load_lds_dwordx4 %3, %6\n\t"
                 "s_add_u32 m0, m0, 0x400\n\ts_nop 0\n\tglobal_load_lds_dwordx4 %3, %7\n\t"
                 "s_mov_b32 m0, %0"
                 : "=&s"(keep) : "v"(vk0), "v"(vk1), "v"(vv), "s"(b0), "s"(b1), "s"(b2), "s"(b3), "s"(kdst) : "memory", "scc"); }
__device__ __forceinline__ void glds_sw_pair(unsigned o0, unsigned o1, const void* b, unsigned dst) { unsigned keep;
    asm volatile("s_mov_b32 %0, m0\n\ts_mov_b32 m0, %4\n\ts_nop 0\n\tglobal_load_lds_dwordx4 %1, %3\n\t"
                 "s_add_u32 m0, m0, 0x400\n\ts_nop 0\n\tglobal_load_lds_dwordx4 %2, %3\n\t"
                 "s_mov_b32 m0, %0"
                 : "=&s"(keep) : "v"(o0), "v"(o1), "s"(b), "s"(dst) : "memory", "scc"); }
__device__ __forceinline__ const char* uni_ptr(const char* p) { const unsigned long long a = (unsigned long long)p;
    return (const char*)(((unsigned long long)(unsigned)__builtin_amdgcn_readfirstlane((int)(a >> 32)) << 32) | (unsigned)__builtin_amdgcn_readfirstlane((int)(unsigned)a)); }
#define ATT_GLDS(src, dst) glds16((const void*)(src), (unsigned)__builtin_amdgcn_readfirstlane((int)(unsigned)(unsigned long long)(dst)))

#ifndef DIAG
#define DIAG 0
#endif
#define ATT_STAMP() (DIAG ? __builtin_amdgcn_s_memrealtime() : 0ull)
#define ATT_DACC(k, dt) do { if (DIAG && threadIdx.x == 0) { volatile ATT_LAS unsigned* D_ = (volatile ATT_LAS unsigned*)(lds + 131072 + 320 + 80); D_[k] = D_[k] + (unsigned)(dt); } } while (0)
template <bool NA>
__device__ __forceinline__ void block_step(const ATT_LAS unsigned char* ks, const ATT_LAS unsigned char* vs, const int (&kro)[4], int vro, const bf16x8 (&qf)[4], f32x16& o0, f32x16& o1, float& m, float& lpart,
                                           bool rv, int delta, unsigned lim, const ATT_LAS float* Tb, ATT_LAS float* wsf, bool first, int q, int hi) {
    f32x16 acc;
    if (NA) {
        f32x16 tv;
#pragma unroll
        for (int r = 0; r < 16; ++r) tv[r] = Tb[ATT_OFF(r)];
        asm volatile("" : "+v"(tv));
#pragma unroll
        for (int r = 0; r < 16; ++r) acc[r] = (rv && ((unsigned)(delta + ATT_OFF(r)) < lim)) ? tv[r] : -INFINITY;
    } else {
#pragma unroll
        for (int r = 0; r < 16; ++r) acc[r] = (rv && ((unsigned)(delta + ATT_OFF(r)) < lim)) ? 0.f : -INFINITY;
    }
#pragma unroll
    for (int s = 0; s < 4; ++s) { const bf16x8 kf = *(const ATT_LAS bf16x8*)(ks + kro[s]); acc = __builtin_amdgcn_mfma_f32_32x32x16_bf16(kf, qf[s], acc, 0, 0, 0); }
#define ATT_VF(d0, ksx) ({ const s16x4 lo_ = vtr(vs + vro + (((d0) ^ ((vro >> 8) & 1)) * 64) + (ksx) * 2048), hi_ = vtr(vs + vro + (((d0) ^ ((vro >> 8) & 1)) * 64) + (ksx) * 2048 + 1024); (bf16x8){lo_[0], lo_[1], lo_[2], lo_[3], hi_[0], hi_[1], hi_[2], hi_[3]}; })
    __builtin_amdgcn_sched_barrier(0);
    const bf16x8 v00 = ATT_VF(0, 0), v01 = ATT_VF(0, 1), v10 = ATT_VF(1, 0), v11 = ATT_VF(1, 1);
    __builtin_amdgcn_sched_barrier(0);
    const float bm = swapmax_nc(max16(acc));
    const float mnew = max2f(m, bm);
    if (__any(mnew > m + THR)) {
        const float alpha = __builtin_amdgcn_exp2f(m - mnew);
        lpart *= alpha; m = mnew;
        if (!first) {
#pragma unroll
            for (int r = 0; r < 16; ++r) { o0[r] *= alpha; o1[r] *= alpha; }
        }
    }
    float ls = 0.f;
#pragma unroll
    for (int r = 0; r < 16; ++r) { acc[r] = __builtin_amdgcn_exp2f(acc[r] - m); ls += acc[r]; }
    lpart += ls;
    u32x4 pw0, pw1;
    pw0[0] = cvtpk(acc[0], acc[1]); pw0[1] = cvtpk(acc[2], acc[3]); pw0[2] = cvtpk(acc[4], acc[5]); pw0[3] = cvtpk(acc[6], acc[7]);
    pw1[0] = cvtpk(acc[8], acc[9]); pw1[1] = cvtpk(acc[10], acc[11]); pw1[2] = cvtpk(acc[12], acc[13]); pw1[3] = cvtpk(acc[14], acc[15]);
    const bf16x8 pa0 = __builtin_bit_cast(bf16x8, pw0), pa1 = __builtin_bit_cast(bf16x8, pw1);
    {
      o0 = __builtin_amdgcn_mfma_f32_32x32x16_bf16(v00, pa0, o0, 0, 0, 0); o1 = __builtin_amdgcn_mfma_f32_32x32x16_bf16(v10, pa0, o1, 0, 0, 0);
      o0 = __builtin_amdgcn_mfma_f32_32x32x16_bf16(v01, pa1, o0, 0, 0, 0); o1 = __builtin_amdgcn_mfma_f32_32x32x16_bf16(v11, pa1, o1, 0, 0, 0); }
#undef ATT_VF
}

template <bool NA, bool MASK>
__device__ __forceinline__ void block_step2(const ATT_LAS unsigned char* ks, const ATT_LAS unsigned char* vs, const int (&kro)[4], int vro, const bf16x8 (&qfA)[4], const bf16x8 (&qfB)[4],
                                            f32x16& oA0, f32x16& oA1, f32x16& oB0, f32x16& oB1, float& mA, float& lpA, float& mB, float& lpB,
                                            bool rvA, bool rvB, int deltaA, int deltaB, unsigned lim, const ATT_LAS float* TbA, const ATT_LAS float* TbB, ATT_LAS float* wsf, int q, int hi, int dbg = 0, ATT_LAS unsigned char* lds = nullptr) {
    const unsigned long long tq0 = ATT_STAMP();
    f32x16 accA, accB;
    if (NA) {
        f32x16 ta, tb;
#pragma unroll
        for (int r = 0; r < 16; ++r) { ta[r] = TbA[ATT_OFF(r)]; tb[r] = TbB[ATT_OFF(r)]; }
        asm volatile("" : "+v"(ta), "+v"(tb));
#pragma unroll
        for (int r = 0; r < 16; ++r) { const bool okc = ((unsigned)(deltaA + ATT_OFF(r)) < lim); accA[r] = (rvA && okc) ? ta[r] : -INFINITY; accB[r] = (rvB && okc) ? tb[r] : -INFINITY; }
    } else {
#pragma unroll
        for (int r = 0; r < 16; ++r) {
            if (MASK) { accA[r] = ((unsigned)(deltaA + ATT_OFF(r)) < lim) ? 0.f : -INFINITY; accB[r] = ((unsigned)(deltaB + ATT_OFF(r)) < lim) ? 0.f : -INFINITY; }
            else { accA[r] = 0.f; accB[r] = 0.f; }
        }
    }
    bf16x8 kf[4];
#pragma unroll
    for (int s = 0; s < 4; ++s) kf[s] = *(const ATT_LAS bf16x8*)(ks + kro[s]);
#pragma unroll
    for (int s = 0; s < 4; ++s) accA = __builtin_amdgcn_mfma_f32_32x32x16_bf16(kf[s], qfA[s], accA, 0, 0, 0);
#pragma unroll
    for (int s = 0; s < 4; ++s) accB = __builtin_amdgcn_mfma_f32_32x32x16_bf16(kf[s], qfB[s], accB, 0, 0, 0);
#define ATT_VF(d0, ksx) ({ const s16x4 lo_ = vtr(vs + vro + (((d0) ^ ((vro >> 8) & 1)) * 64) + (ksx) * 2048), hi_ = vtr(vs + vro + (((d0) ^ ((vro >> 8) & 1)) * 64) + (ksx) * 2048 + 1024); (bf16x8){lo_[0], lo_[1], lo_[2], lo_[3], hi_[0], hi_[1], hi_[2], hi_[3]}; })
    __builtin_amdgcn_sched_barrier(0);
    const bf16x8 v00 = ATT_VF(0, 0), v10 = ATT_VF(1, 0), v01 = ATT_VF(0, 1), v11 = ATT_VF(1, 1);
    __builtin_amdgcn_sched_barrier(0);
    {   const float bmA = swapmax_nc(max16(accA)); const float mnA = max2f(mA, bmA);
        if (__any(mnA > mA + THR)) { const float alA = __builtin_amdgcn_exp2f(mA - mnA); lpA *= alA; mA = mnA;
#pragma unroll
            for (int r = 0; r < 16; ++r) { oA0[r] *= alA; oA1[r] *= alA; } } }
    __builtin_amdgcn_sched_barrier(0);
    float lsA = 0.f;
#pragma unroll
    for (int r = 0; r < 16; ++r) { accA[r] = __builtin_amdgcn_exp2f(accA[r] - mA); lsA += accA[r]; }
    lpA += lsA;
    u32x4 a0, a1;
    a0[0] = cvtpk(accA[0], accA[1]); a0[1] = cvtpk(accA[2], accA[3]); a0[2] = cvtpk(accA[4], accA[5]); a0[3] = cvtpk(accA[6], accA[7]);
    a1[0] = cvtpk(accA[8], accA[9]); a1[1] = cvtpk(accA[10], accA[11]); a1[2] = cvtpk(accA[12], accA[13]); a1[3] = cvtpk(accA[14], accA[15]);
    const bf16x8 paA0 = __builtin_bit_cast(bf16x8, a0), paA1 = __builtin_bit_cast(bf16x8, a1);
    __builtin_amdgcn_sched_barrier(0);
    oA0 = __builtin_amdgcn_mfma_f32_32x32x16_bf16(v00, paA0, oA0, 0, 0, 0); oA1 = __builtin_amdgcn_mfma_f32_32x32x16_bf16(v10, paA0, oA1, 0, 0, 0);
    {   const float bmB = swapmax_nc(max16(accB)); const float mnB = max2f(mB, bmB);
        if (__any(mnB > mB + THR)) { const float alB = __builtin_amdgcn_exp2f(mB - mnB); lpB *= alB; mB = mnB;
#pragma unroll
            for (int r = 0; r < 16; ++r) { oB0[r] *= alB; oB1[r] *= alB; } } }
    __builtin_amdgcn_sched_barrier(0);
    oA0 = __builtin_amdgcn_mfma_f32_32x32x16_bf16(v01, paA1, oA0, 0, 0, 0); oA1 = __builtin_amdgcn_mfma_f32_32x32x16_bf16(v11, paA1, oA1, 0, 0, 0);
    __builtin_amdgcn_sched_barrier(0);
    float lsB = 0.f;
#pragma unroll
    for (int r = 0; r < 16; ++r) { accB[r] = __builtin_amdgcn_exp2f(accB[r] - mB); lsB += accB[r]; }
    lpB += lsB;
    u32x4 b0, b1;
    b0[0] = cvtpk(accB[0], accB[1]); b0[1] = cvtpk(accB[2], accB[3]); b0[2] = cvtpk(accB[4], accB[5]); b0[3] = cvtpk(accB[6], accB[7]);
    b1[0] = cvtpk(accB[8], accB[9]); b1[1] = cvtpk(accB[10], accB[11]); b1[2] = cvtpk(accB[12], accB[13]); b1[3] = cvtpk(accB[14], accB[15]);
    const bf16x8 paB0 = __builtin_bit_cast(bf16x8, b0), paB1 = __builtin_bit_cast(bf16x8, b1);
    __builtin_amdgcn_sched_barrier(0);
    oB0 = __builtin_amdgcn_mfma_f32_32x32x16_bf16(v00, paB0, oB0, 0, 0, 0); oB1 = __builtin_amdgcn_mfma_f32_32x32x16_bf16(v10, paB0, oB1, 0, 0, 0);
    oB0 = __builtin_amdgcn_mfma_f32_32x32x16_bf16(v01, paB1, oB0, 0, 0, 0); oB1 = __builtin_amdgcn_mfma_f32_32x32x16_bf16(v11, paB1, oB1, 0, 0, 0);
#undef ATT_VF
}

template <bool NA>
__device__ __forceinline__ void unit_epilogue(ATT_LAS unsigned char* lds, ATT_LAS float* wsf, const f32x16& oa0, const f32x16& oa1, const f32x16& ob0, const f32x16& ob1, float lp0, float lp1,
                                              unsigned short* OB, int tokq0, int tokq1, int wave, int lane) {
    asm volatile("" : "+v"(lane)); const int q = lane & 31, hi = lane >> 5;
    const float i0 = __builtin_amdgcn_rcpf(swapsum(lp0)), i1 = __builtin_amdgcn_rcpf(swapsum(lp1));
    float s0 = 0.f, s1 = 0.f;
#pragma unroll
    for (int r = 0; r < 16; ++r) { s0 += oa0[r] * oa0[r] + oa1[r] * oa1[r]; s1 += ob0[r] * ob0[r] + ob1[r] * ob1[r]; }
    s0 = swapsum(s0) * (i0 * i0); s1 = swapsum(s1) * (i1 * i1);
    ATT_LAS float* P8 = (ATT_LAS float*)(lds + LDS_SCR);
    if (hi == 0) { P8[q * 8 + wave] = s0; P8[(32 + q) * 8 + wave] = s1; }
    asm volatile("s_waitcnt vmcnt(0) lgkmcnt(0)" ::: "memory"); __builtin_amdgcn_s_barrier(); asm volatile("" ::: "memory");
    float c0, c1;
    {   const f32x4 a0 = *(const ATT_LAS f32x4*)(P8 + q * 8), a1 = *(const ATT_LAS f32x4*)(P8 + q * 8 + 4), b0 = *(const ATT_LAS f32x4*)(P8 + (32 + q) * 8), b1 = *(const ATT_LAS f32x4*)(P8 + (32 + q) * 8 + 4);
        const float t0 = ((a0[0] + a0[1]) + (a0[2] + a0[3])) + ((a1[0] + a1[1]) + (a1[2] + a1[3])), t1 = ((b0[0] + b0[1]) + (b0[2] + b0[3])) + ((b1[0] + b1[1]) + (b1[2] + b1[3]));
        c0 = i0 * __builtin_amdgcn_rsqf(t0 * (1.0f / 512.0f) + RMS_EPS); c1 = i1 * __builtin_amdgcn_rsqf(t1 * (1.0f / 512.0f) + RMS_EPS); }
    const ATT_LAS float* G = (const ATT_LAS float*)(lds + LDS_GTAB) + (NA ? 0 : 512) + wave * 64 + 4 * hi;
    ATT_LAS unsigned char* TA = lds + q * TPITCH + (wave * 64 + 4 * hi) * 2;
#pragma unroll
    for (int blk = 0; blk < 2; ++blk)
#pragma unroll
        for (int c = 0; c < 4; ++c) {
            const f32x4 g = *(const ATT_LAS f32x4*)(G + 32 * blk + 8 * c);
            const f32x16& xa = blk ? oa1 : oa0; const f32x16& xb = blk ? ob1 : ob0;
            typedef unsigned u32x2_t __attribute__((ext_vector_type(2)));
            u32x2_t wa, wb;
            wa[0] = cvtpk(xa[4 * c] * c0 * g[0], xa[4 * c + 1] * c0 * g[1]); wa[1] = cvtpk(xa[4 * c + 2] * c0 * g[2], xa[4 * c + 3] * c0 * g[3]);
            wb[0] = cvtpk(xb[4 * c] * c1 * g[0], xb[4 * c + 1] * c1 * g[1]); wb[1] = cvtpk(xb[4 * c + 2] * c1 * g[2], xb[4 * c + 3] * c1 * g[3]);
            *(ATT_LAS u32x2_t*)(TA + (32 * blk + 8 * c) * 2) = wa; *(ATT_LAS u32x2_t*)(TA + 32 * TPITCH + (32 * blk + 8 * c) * 2) = wb;
        }
    asm volatile("s_waitcnt lgkmcnt(0)" ::: "memory"); __builtin_amdgcn_s_barrier(); asm volatile("" ::: "memory");
    const int t = lane & 15, rsub = lane >> 4;
#pragma unroll
    for (int p = 0; p < 2; ++p) {
        const int row = 8 * wave + 4 * p + rsub;
        const int qq = row & 31, tq = (row >> 5) ? tokq1 : tokq0;
        const int otok = NA ? tq + (qq >> 4) * 64 + (qq & 15) : tq + qq;
        unsigned short* orow = OB + (size_t)otok * DOUT + (NA ? 0 : 512) + 8 * t;
        u32x4 w[4];
#pragma unroll
        for (int j = 0; j < 4; ++j) w[j] = *(const ATT_LAS u32x4*)(lds + row * TPITCH + (128 * j + 8 * t) * 2);
#pragma unroll
        for (int j = 0; j < 4; ++j) asm volatile("global_store_dwordx4 %0, %1, off sc1\n\ts_nop 1" :: "v"(orow + 128 * j), "v"(w[j]) : "memory");
    }
    asm volatile("s_waitcnt lgkmcnt(0)" ::: "memory"); __builtin_amdgcn_s_barrier(); asm volatile("" ::: "memory");
}

template <bool NA>
__device__ __forceinline__ void attn_unit(ATT_LAS unsigned char* lds, const unsigned short* __restrict__ PROJ, unsigned short* OB, const float* __restrict__ gout, const float* __restrict__ sink, int u, int wave, int lane, int dbg = 0) {
    const unsigned long long ts0 = ATT_STAMP();
    wave = __builtin_amdgcn_readfirstlane(wave);
    asm volatile("" : "+v"(lane));
    const int q = lane & 31, hi = lane >> 5;
    ATT_LAS float* wsf = (ATT_LAS float*)(lds + LDS_SCR) + wave * 64;
    const ATT_LAS float* T = (const ATT_LAS float*)(lds + LDS_BIAS);
    const int b = u >> 5;
    int jn, tok0, tokstep, qoff, jlo0, jhi0, jlo1, jhi1, qtok0, qtok1, delta0, delta1, dstep, bidx0 = 0, bidx1 = 0, sr0 = 0, sr1 = 0, kr0 = 0, tokq0, tokq1; unsigned lim; float m0, m1, lp0, lp1;
    if (NA) {
        const int R = (u >> 2) & 7, cb = u & 3;
        const int h0c = min(max(16 * cb - 8, 0), 32);
        const int qc = 16 * cb + (q & 15), sc = min(max(qc - 8, 0), 48);
        const int qr0 = 4 * R + (q >> 4), qr1 = qr0 + 2;
        sr0 = min(max(qr0 - 4, 0), 24); sr1 = min(max(qr1 - 4, 0), 24);
        const int rlo0 = min(max(4 * R - 4, 0), 24), rhi0 = min(max(4 * R - 3, 0), 24) + 8, rlo1 = min(max(4 * R - 2, 0), 24), rhi1 = min(max(4 * R - 1, 0), 24) + 8;
        kr0 = rlo0; jn = rhi1 - rlo0; jlo0 = 0; jhi0 = rhi0 - rlo0; jlo1 = rlo1 - rlo0; jhi1 = jn;
        tok0 = b * SEQ + rlo0 * 64 + h0c; tokstep = 64; qoff = 64 * wave;
        qtok0 = b * SEQ + qr0 * 64 + qc; qtok1 = qtok0 + 128; tokq0 = b * SEQ + 4 * R * 64 + 16 * cb; tokq1 = tokq0 + 128;
        delta0 = delta1 = h0c + 4 * hi - sc; dstep = 0; lim = 16u;
        bidx0 = wave * 465 + (rlo0 - qr0 + 7) * 31 + (h0c + 4 * hi - qc + 15); bidx1 = bidx0 - 2 * 31;
        m0 = m1 = -1e30f; lp0 = lp1 = 0.f;
    } else {
        const int q0 = 64 * (u & 31);
        const int kfirst = max(q0 - 128, 0), kend = min(q0 + 192, SEQ);
        jn = (kend - kfirst) >> 5; tok0 = b * SEQ + kfirst; tokstep = 32; qoff = 1536 + 64 * wave;
        jlo0 = 0; jhi0 = (min(q0 + 160, kend) - kfirst) >> 5; jlo1 = (max(q0 - 96, kfirst) - kfirst) >> 5; jhi1 = jn;
        qtok0 = b * SEQ + q0 + q; qtok1 = qtok0 + 32; tokq0 = b * SEQ + q0; tokq1 = tokq0 + 32;
        delta0 = kfirst + 4 * hi - (q0 + q) + 128; delta1 = delta0 - 32; dstep = 32; lim = 257u;
        m0 = m1 = sink[wave] * LOG2E; lp0 = lp1 = hi == 0 ? 1.0f : 0.f;
    }
    int kro[4];
#pragma unroll
    for (int s = 0; s < 4; ++s) kro[s] = q * 128 + 16 * ((2 * s + hi) ^ ((q >> 1) & 7));
    const int vro = ((lane >> 4) & 1) * 32 + (lane & 3) * 8 + (4 * hi + ((lane & 15) >> 2)) * 128;
    bf16x8 qf0[4], qf1[4];
    bf16x8 qta[4], qtb[4];
    {   const int rr0 = lane >> 3, ch = lane & 7;
#pragma unroll
        for (int i = 0; i < 4; ++i) { const int qq = 8 * i + rr0; const int tq = NA ? (qq >> 4) * 64 + (qq & 15) : qq;
            qta[i] = *(const bf16x8*)(PROJ + (size_t)(tokq0 + tq) * NIN + qoff + 8 * ch); qtb[i] = *(const bf16x8*)(PROJ + (size_t)(tokq1 + tq) * NIN + qoff + 8 * ch); } }
#define ATT_WAIT_Q(sq0, sq1) do { __builtin_amdgcn_s_waitcnt(0x0F70); asm volatile("" ::: "memory"); \
        { const int rr0_ = lane >> 3, ch_ = lane & 7; \
          _Pragma("unroll") for (int i = 0; i < 4; ++i) { const int qq_ = 8 * i + rr0_; const int o_ = qq_ * 128 + ((ch_ ^ (qq_ & 7)) * 16); \
              *(ATT_LAS bf16x8*)((sq0) + o_) = qta[i]; *(ATT_LAS bf16x8*)((sq1) + o_) = qtb[i]; } } \
        asm volatile("s_waitcnt lgkmcnt(0)" ::: "memory"); \
        _Pragma("unroll") for (int s = 0; s < 4; ++s) { const int o_ = q * 128 + (((2 * s + hi) ^ (q & 7)) * 16); qf0[s] = *(const ATT_LAS bf16x8*)((sq0) + o_); qf1[s] = *(const ATT_LAS bf16x8*)((sq1) + o_); } \
        asm volatile("s_waitcnt lgkmcnt(0)" ::: "memory"); } while (0)
    const unsigned long long ts1 = ATT_STAMP();
    f32x16 oa0 = {}, oa1 = {}, ob0 = {}, ob1 = {};
    if (NA) {
        ATT_LAS unsigned char* ring = lds + wave * WAVE_RING;
        const int koff = 512 + 64 * wave, voff = 1024 + 64 * wave;
        const int kso0 = (lane >> 3) * NIN + koff + 8 * ((lane & 7) ^ (lane >> 4));
        const int kso1 = (lane >> 3) * NIN + koff + 8 * ((lane & 7) ^ (4 + (lane >> 4)));
        const int vso = (lane >> 3) * NIN + voff + 8 * ((lane & 7) ^ (4 * ((lane >> 4) & 1)));
        const unsigned vk0 = 2u * (unsigned)kso0, vk1 = 2u * (unsigned)kso1, vv = 2u * (unsigned)vso;
#define ATT_DMA_NA(tok, slot) do { const char* gb_ = uni_ptr((const char*)(PROJ + (size_t)(tok) * NIN)); \
        glds_na_block(vk0, vk1, vv, gb_, gb_ + 8 * NIN * 2, gb_ + 16 * NIN * 2, gb_ + 24 * NIN * 2, (unsigned)__builtin_amdgcn_readfirstlane((int)(unsigned)(unsigned long long)(ring + (slot) * 4096))); } while (0)
        ATT_DMA_NA(tok0, 0);
        ATT_WAIT_Q(ring + 4096, ring + 12288);
#define ATT_NA_HEAD() int slot = j & 1; asm volatile("" : "+s"(slot)); \
            asm volatile("s_waitcnt vmcnt(0)" ::: "memory"); \
            if (j + 1 < jn && !(dbg & 2)) ATT_DMA_NA(tok0 + (j + 1) * tokstep, slot ^ 1); \
            const ATT_LAS unsigned char* ks = ring + slot * 4096; const ATT_LAS unsigned char* vs = ring + 8192 + slot * 4096; \
            const int kr = kr0 + j; const bool rv0 = (kr >= sr0) && (kr < sr0 + 8), rv1 = (kr >= sr1) && (kr < sr1 + 8); (void)rv0; (void)rv1;
        int j = 0;
        for (; j < jn && j < jlo1; ++j) { ATT_NA_HEAD(); if (dbg & 1) continue; block_step<true>(ks, vs, kro, vro, qf0, oa0, oa1, m0, lp0, rv0, delta0, lim, T + bidx0 + 31 * j, wsf, j == 0, q, hi); }
        for (; j < jn && j < jhi0; ++j) { ATT_NA_HEAD(); if (dbg & 1) continue;
            block_step2<true, true>(ks, vs, kro, vro, qf0, qf1, oa0, oa1, ob0, ob1, m0, lp0, m1, lp1, rv0, rv1, delta0, delta1, lim, T + bidx0 + 31 * j, T + bidx1 + 31 * j, wsf, q, hi, dbg); }
        for (; j < jn; ++j) { ATT_NA_HEAD(); if (dbg & 1) continue; block_step<true>(ks, vs, kro, vro, qf1, ob0, ob1, m1, lp1, rv1, delta1, lim, T + bidx1 + 31 * j, wsf, false, q, hi); }
#undef ATT_NA_HEAD
#undef ATT_DMA_NA
    } else {
        const int arr = wave >> 1, kvh_dma = arr & 1, p0 = 2 * (wave & 1);
        int so0, so1;
        if (arr < 2) { const int kc = 2048 + 64 * kvh_dma; so0 = (8 * p0 + (lane >> 3)) * NIN + kc + 8 * ((lane & 7) ^ (lane >> 4)); so1 = (8 * (p0 + 1) + (lane >> 3)) * NIN + kc + 8 * ((lane & 7) ^ (4 + (lane >> 4))); }
        else { const int vc = 2176 + 64 * kvh_dma + 8 * ((lane & 7) ^ (4 * ((lane >> 4) & 1))); so0 = (8 * p0 + (lane >> 3)) * NIN + vc; so1 = (8 * (p0 + 1) + (lane >> 3)) * NIN + vc; }
        ATT_LAS unsigned char* dst0 = lds + arr * 4096 + p0 * 1024;
        const unsigned vo0 = 2u * (unsigned)so0, vo1 = 2u * (unsigned)so1;
#define ATT_DMA_SW(jj) do { const int jc_ = (jj) < jn ? (jj) : jn - 1; const char* gb_ = uni_ptr((const char*)(PROJ + (size_t)(tok0 + jc_ * tokstep) * NIN)); int so_ = ((jj) & 3) * SH_SLOT; asm volatile("" : "+s"(so_)); \
        glds_sw_pair(vo0, vo1, gb_, (unsigned)__builtin_amdgcn_readfirstlane((int)(unsigned)(unsigned long long)(dst0 + so_))); } while (0)
        ATT_DMA_SW(0); ATT_DMA_SW(1); ATT_DMA_SW(2);
        ATT_WAIT_Q(lds + 65536 + wave * 8192, lds + 65536 + wave * 8192 + 4096);
        const int kvh = wave >> 2;
        const int kb0 = tok0 - b * SEQ, qg0 = tokq0 - b * SEQ, qg1 = qg0 + 32;
#define ATT_SW_HEAD() asm volatile("s_waitcnt vmcnt(4) lgkmcnt(0)" ::: "memory"); __builtin_amdgcn_s_barrier(); asm volatile("" ::: "memory"); \
            if (!(dbg & 2)) ATT_DMA_SW(j + 3); \
            int sb = (j & 3) * SH_SLOT + kvh * 4096; asm volatile("" : "+s"(sb)); \
            const ATT_LAS unsigned char* ks = lds + sb; const ATT_LAS unsigned char* vs = lds + sb + 8192;
#define ATT_SW_FULL(jj) ((kb0 + 32 * (jj) >= qg0 - 97) && (kb0 + 32 * (jj) <= qg0 + 97) && (kb0 + 32 * (jj) >= qg1 - 97) && (kb0 + 32 * (jj) <= qg1 + 97))
        int j = 0;
        for (; j < jn && j < jlo1; ++j) { ATT_SW_HEAD(); if (dbg & 1) continue; block_step<false>(ks, vs, kro, vro, qf0, oa0, oa1, m0, lp0, true, delta0 + 32 * j, lim, T, wsf, j == 0, q, hi); }
        for (; j < jn && j < jhi0 && !ATT_SW_FULL(j); ++j) { ATT_SW_HEAD(); if (dbg & 1) continue;
            block_step2<false, true>(ks, vs, kro, vro, qf0, qf1, oa0, oa1, ob0, ob1, m0, lp0, m1, lp1, true, true, delta0 + 32 * j, delta1 + 32 * j, lim, T, T, wsf, q, hi, dbg, lds); }
        for (; j < jn && j < jhi0 && ATT_SW_FULL(j); ++j) { ATT_SW_HEAD(); if (dbg & 1) continue;
            block_step2<false, false>(ks, vs, kro, vro, qf0, qf1, oa0, oa1, ob0, ob1, m0, lp0, m1, lp1, true, true, delta0 + 32 * j, delta1 + 32 * j, lim, T, T, wsf, q, hi, dbg, lds); }
        for (; j < jn && j < jhi0; ++j) { ATT_SW_HEAD(); if (dbg & 1) continue;
            block_step2<false, true>(ks, vs, kro, vro, qf0, qf1, oa0, oa1, ob0, ob1, m0, lp0, m1, lp1, true, true, delta0 + 32 * j, delta1 + 32 * j, lim, T, T, wsf, q, hi, dbg, lds); }
        for (; j < jn; ++j) { ATT_SW_HEAD(); if (dbg & 1) continue; block_step<false>(ks, vs, kro, vro, qf1, ob0, ob1, m1, lp1, true, delta1 + 32 * j, lim, T, wsf, false, q, hi); }
#undef ATT_SW_HEAD
#undef ATT_SW_FULL
#undef ATT_DMA_SW
    }
    const unsigned long long ts2 = ATT_STAMP();
    if (dbg & 4) { asm volatile("s_waitcnt vmcnt(0) lgkmcnt(0)" :: "v"(oa0[0]), "v"(oa1[3]), "v"(ob0[5]), "v"(ob1[7]), "v"(lp0), "v"(lp1) : "memory"); __builtin_amdgcn_s_barrier(); return; }
    unit_epilogue<NA>(lds, wsf, oa0, oa1, ob0, ob1, lp0, lp1, OB, tokq0, tokq1, wave, lane);
    const unsigned long long ts3 = ATT_STAMP();
    ATT_DACC(NA ? 0 : 3, ts3 - ts0); ATT_DACC(NA ? 1 : 4, ts2 - ts1); ATT_DACC(2, ts1 - ts0);
}

__device__ __forceinline__ void attn_setup(ATT_LAS unsigned char* lds, const float* rpb, const float* g_na, const float* g_swa, int tid) {
    ATT_LAS float* T = (ATT_LAS float*)(lds + LDS_BIAS);
    for (int i = tid; i < NBIAS; i += 512) T[i] = rpb[i] * LOG2E;
    { ATT_LAS float* G = (ATT_LAS float*)(lds + LDS_GTAB); G[tid] = g_na[tid]; G[512 + tid] = g_swa[tid]; }
    asm volatile("s_waitcnt vmcnt(0) lgkmcnt(0)" ::: "memory"); __builtin_amdgcn_s_barrier(); asm volatile("" ::: "memory");
}
}
#define GAS __attribute__((address_space(1)))
#define LAS __attribute__((address_space(3)))
typedef unsigned short bf16;
typedef unsigned v4u __attribute__((ext_vector_type(4)));
typedef float f32x4 __attribute__((ext_vector_type(4)));
typedef short bf16x8 __attribute__((ext_vector_type(8)));
typedef GAS unsigned gu32;
typedef GAS unsigned long long gu64;
#define RLX_AGENT __ATOMIC_RELAXED, __HIP_MEMORY_SCOPE_AGENT
#define LDS_WAIT() asm volatile("s_waitcnt lgkmcnt(0)" ::: "memory")
#define VM_WAIT() asm volatile("s_waitcnt vmcnt(0)" ::: "memory")
__device__ __forceinline__ unsigned long long rt() { return __builtin_amdgcn_s_memrealtime(); }
__device__ __forceinline__ unsigned f2bf(float f) { unsigned u = __builtin_bit_cast(unsigned, f); return (u + 0x7fffu + ((u >> 16) & 1u)) >> 16; }
__device__ __forceinline__ unsigned pk2(float lo, float hi) { return f2bf(lo) | (f2bf(hi) << 16); }

#define XB_TMO      128
#define XB_XCNT(j)  (256  + 64 * (j))
#define XB_XSUB(j)  (1280 + 64 * (j))
#define XB_XGEN(j)  (2304 + 64 * (j))
#define XB_TOP      3328
#define XB_TOPGEN   3392
#define XCD_BAR_WORDS 3456
#define XB_SPIN_CAP (1u << 18)

__device__ __forceinline__ unsigned xb_ld(unsigned* p)              { return __hip_atomic_load(p, __ATOMIC_RELAXED, __HIP_MEMORY_SCOPE_AGENT); }
__device__ __forceinline__ unsigned xb_add(unsigned* p, unsigned v) { return __hip_atomic_fetch_add(p, v, __ATOMIC_RELAXED, __HIP_MEMORY_SCOPE_AGENT); }
__device__ __forceinline__ unsigned xb_xcc_id() { return (unsigned)__builtin_amdgcn_s_getreg((3 << 11) | 20) & 0xFu; }
#define XB_SPIN(cond, bar) do { unsigned _sp = 0; while (cond) { __builtin_amdgcn_s_sleep(1); \
    if ((++_sp & 255u) == 0u) { if (xb_ld(&(bar)[XB_TMO])) break; if (_sp > XB_SPIN_CAP) { atomicAdd(&(bar)[XB_TMO], 1u); break; } } } } while (0)

struct XcdBarrier {
    unsigned* bar; unsigned x;
    volatile LAS unsigned* st;
};

__device__ __forceinline__ XcdBarrier xcd_barrier_post(unsigned* bar, volatile LAS unsigned* st) {
    XcdBarrier b; b.bar = bar; b.x = xb_xcc_id(); b.st = st;
    if (threadIdx.x == 0) (void)xb_add(&bar[XB_XCNT(b.x)], 1u);
    return b;
}
__device__ __forceinline__ void xcd_barrier_complete(unsigned* bar, unsigned x, unsigned& nloc, unsigned& nx) {
    const unsigned G = gridDim.x * gridDim.y * gridDim.z;
    unsigned sum, cnt, mine, sp = 0u;
    for (;;) {
        sum = 0u; cnt = 0u; mine = 0u;
#pragma unroll
        for (unsigned j = 0; j < 16; ++j) { const unsigned c = xb_ld(&bar[XB_XCNT(j)]); sum += c; cnt += (c > 0u) ? 1u : 0u; mine = (j == x) ? c : mine; }
        if (sum == G) break;
        __builtin_amdgcn_s_sleep(1);
        if ((++sp & 255u) == 0u) { if (xb_ld(&bar[XB_TMO])) break; if (sp > XB_SPIN_CAP) { atomicAdd(&bar[XB_TMO], 1u); break; } }
    }
    nloc = mine > 0u ? mine : 1u; nx = cnt > 0u ? cnt : 1u;
}

__device__ __forceinline__ void xcd_barrier(const XcdBarrier& b) {
    asm volatile("s_waitcnt vmcnt(0)" ::: "memory");
    __syncthreads();
    if (threadIdx.x == 0) {
        unsigned* bar = b.bar;
        __builtin_amdgcn_s_waitcnt(0);
        unsigned nloc = b.st[0], nx = b.st[1];
        if (nloc == 0u) { xcd_barrier_complete(bar, b.x, nloc, nx); b.st[0] = nloc; b.st[1] = nx; }
        const unsigned old = xb_add(&bar[XB_XSUB(b.x)], 1u);
        const unsigned gen = old / nloc;
        if (old + 1u == (gen + 1u) * nloc) {
            __builtin_amdgcn_fence(__ATOMIC_RELEASE, "agent");
            asm volatile("s_waitcnt vmcnt(0)" ::: "memory");
            const unsigned og = xb_add(&bar[XB_TOP], 1u);
            const unsigned tg = og / nx;
            if (og + 1u == (tg + 1u) * nx) xb_add(&bar[XB_TOPGEN], 1u);
            else XB_SPIN(xb_ld(&bar[XB_TOPGEN]) == tg, bar);
            __builtin_amdgcn_fence(__ATOMIC_ACQUIRE, "agent");
            xb_add(&bar[XB_XGEN(b.x)], 1u);
            asm volatile("s_waitcnt vmcnt(0)" ::: "memory");
        } else {
            XB_SPIN(xb_ld(&bar[XB_XGEN(b.x)]) == gen, bar);
            __builtin_amdgcn_fence(__ATOMIC_ACQUIRE, "agent");
            asm volatile("s_waitcnt vmcnt(0)" ::: "memory");
        }
    }
    __syncthreads();
}

constexpr int NWAVES = 8;
constexpr int BATCH = 8, SEQ = 2048, D = 1024, M = BATCH * SEQ, NIN = 2304, DFF = 2816, NGU = 2 * DFF;
constexpr int GU_FULL = 20 * 256;
static_assert(NGU - GU_FULL == 4 * 128 && (GU_FULL / 2) % 128 == 0, "P4 tail: four half-N units");
constexpr float RMS_EPS = 1e-6f;
constexpr float LOG2E = 1.4426950408889634f;
constexpr int N_PHASES = 6;
#ifndef DIAG_Q
#define DIAG_Q 16
#endif
#ifndef DIAG_DIV
#define DIAG_DIV 10
#endif
#ifndef DIAG_A0
#define DIAG_A0 1
#define DIAG_A1 0
#define DIAG_B0 4
#define DIAG_B1 3
#endif
#ifndef DIAG_BLOCK
#define DIAG_BLOCK 100
#endif
#ifndef DATAFLOW
#define DATAFLOW 1
#endif
#ifndef SELFZERO
#if defined(PROBE_CHAIN) || defined(PROBE_TWICE) || (defined(PROBE_PH) && PROBE_PH >= 0)
#define SELFZERO 0
#else
#define SELFZERO 1
#endif
#endif
#ifndef PROBE_DBG
#define PROBE_DBG 0
#endif
#ifndef PROBE_ATTN_ONLY
#define PROBE_ATTN_ONLY 0
#endif
#ifndef PROBE_PH
#define PROBE_PH -1
#endif

constexpr size_t MiB = 1u << 20;
constexpr size_t WS_CTL = 0, CTL_ZERO_BYTES = 512 * 1024;
constexpr size_t WS_CS = 1 * MiB;
constexpr size_t WS_SS = 2 * MiB;
constexpr size_t WS_RS = 3 * MiB + 512 * 1024;
constexpr size_t WS_XB = 3 * MiB;
constexpr size_t WS_WIN = 4 * MiB, WS_WOUT = 9 * MiB, WS_WGU = 11 * MiB, WS_WD = 22 * MiB;
constexpr size_t WS_O = 32 * MiB;
constexpr size_t WS_XN = 64 * MiB;
constexpr size_t WS_PROJ = 96 * MiB;
constexpr size_t WS_H = 168 * MiB;
constexpr size_t WS_END = 256 * MiB;
static_assert(WS_WIN + (size_t)NIN * D * 2 <= WS_WOUT && WS_WOUT + (size_t)D * D * 2 <= WS_WGU && WS_WGU + (size_t)NGU * D * 2 <= WS_WD && WS_WD + (size_t)D * DFF * 2 <= WS_O, "weights map");
static_assert(WS_O + (size_t)M * D * 2 <= WS_XN && WS_XN + (size_t)M * D * 2 <= WS_PROJ && WS_PROJ + (size_t)M * NIN * 2 <= WS_H && WS_H + (size_t)M * DFF * 2 <= WS_END, "activation map");
constexpr int CW_TMO = 0, CW_CODE = 1, CW_P0BAR = 64;
constexpr int CW_BAR = 4096;
constexpr int MAX_LAUNCHES = 4;
constexpr int CW_QUEUE = 24576;
constexpr int CW_GATE = 24576 + 64 * 8;
constexpr int CW_BATCH = 28672;
constexpr int CW_PAN_ATT = 65536, CW_PAN_P3 = CW_PAN_ATT + 4096, CW_PAN_P4 = CW_PAN_P3 + 4096, CW_WCONV = CW_PAN_P4 + 4096;
constexpr int CW_SEAM = 32768;
static_assert(CW_BAR + MAX_LAUNCHES * XCD_BAR_WORDS <= CW_QUEUE && CW_GATE + 64 + (MAX_LAUNCHES - 1) * 1024 <= CW_SEAM && (CW_SEAM + 64 * 64) * 4 <= (int)CTL_ZERO_BYTES && CW_SEAM + 64 * 64 <= CW_PAN_ATT && (CW_WCONV + 64 + (MAX_LAUNCHES - 1) * 16384) * 4 <= (int)CTL_ZERO_BYTES, "CTL map");

constexpr int RING_OFF = 0, RING_BYTES = 131072;
constexpr int LDSCTL_OFF = RING_BYTES, MISC_OFF = LDSCTL_OFF + 320;
constexpr int LDS_BYTES = 163840;
static_assert(MISC_OFF + 128 <= att::LDS_SCR && att::LDS_END <= LDS_BYTES && att::LDS_SCR + 256 * 17 * 4 <= LDS_BYTES, "LDS map");

struct Frame {
    LAS unsigned char* lds;
    volatile LAS unsigned* MISC;
    gu32* ctl;
    int tid, lane, wave;
    int vcu, G;
};

__device__ __forceinline__ float wave_sum(float v) {
#pragma unroll
    for (int o = 1; o < 64; o <<= 1) v += __shfl_xor(v, o);
    return v;
}
__device__ __forceinline__ void p0_transpose_item(const float* W, int K, int N, bf16* WT, int k0, int n0, int out_row0, LAS float* scr, int lane, const float* kscale = nullptr, int half_up = -1) {
    const int kr = lane >> 3, c4 = (lane & 7) * 4;
    f32x4 v[8];
#pragma unroll
    for (int i = 0; i < 8; ++i) v[i] = __builtin_nontemporal_load((const GAS f32x4*)(W + (size_t)(k0 + 8 * i + kr) * N + n0 + c4));
    if (kscale) {
#pragma unroll
        for (int i = 0; i < 8; ++i) v[i] = v[i] * kscale[k0 + 8 * i + kr];
    }
#pragma unroll
    for (int i = 0; i < 8; ++i) { LAS float* d = scr + (8 * i + kr) * 33 + c4; d[0] = v[i].x; d[1] = v[i].y; d[2] = v[i].z; d[3] = v[i].w; }
    LDS_WAIT(); asm volatile("" ::: "memory");
    const int c = lane & 7;
#pragma unroll
    for (int j = 0; j < 4; ++j) { const int n = (lane >> 3) + 8 * j; const LAS float* s = scr + (8 * c) * 33 + n;
        v4u o; o.x = pk2(s[0 * 33], s[1 * 33]); o.y = pk2(s[2 * 33], s[3 * 33]); o.z = pk2(s[4 * 33], s[5 * 33]); o.w = pk2(s[6 * 33], s[7 * 33]);
        const int nn = n0 + n - GU_FULL / 2;
        const int orow = half_up < 0 ? out_row0 + n : GU_FULL + 128 * (nn >> 6) + 32 * ((nn & 63) >> 4) + 8 * ((nn >> 2) & 3) + 4 * half_up + (nn & 3);
        pg8::st16_wt(WT + (size_t)orow * K + k0 + 8 * c, o); }
    LDS_WAIT(); asm volatile("" ::: "memory");
}
__device__ __forceinline__ void row_to_bf16_rstd(int lane, const float* xrow, bf16* orow, float* rs) {
    const GAS f32x4* xr = (const GAS f32x4*)xrow + lane;
    f32x4 v[4]; float s = 0.f;
#pragma unroll
    for (int j = 0; j < 4; ++j) { v[j] = __builtin_nontemporal_load(xr + 64 * j); s += (v[j].x * v[j].x + v[j].y * v[j].y) + (v[j].z * v[j].z + v[j].w * v[j].w); }
    const float rstd = 1.f / sqrtf(wave_sum(s) * (1.f / D) + RMS_EPS);
    if (lane == 0) pg8::st4_wt(rs, rstd);
    unsigned long long* o8 = (unsigned long long*)orow + lane;
#pragma unroll
    for (int j = 0; j < 4; ++j) pg8::st8_wt(o8 + 64 * j, pk2(v[j].x, v[j].y), pk2(v[j].z, v[j].w));
}

struct Args { const float* in[13]; float* out; unsigned char* ws; int ph_lo, ph_hi, li, pad; };

constexpr int I_IN = (D / 64) * (NIN / 32), I_OUT = (D / 64) * (D / 32), I_G = (D / 64) * (DFF / 32), I_D = (DFF / 64) * (D / 32);
constexpr int NITEMS = I_IN + I_OUT + 2 * I_G + I_D;
__device__ __forceinline__ void convert_items(Frame& F, const Args& a, int first, int last, int gw, int NGW) {
    LAS float* scr = (LAS float*)(F.lds + RING_OFF + F.wave * 16384);
    unsigned char* ws = a.ws;
    bf16* Win_t = (bf16*)(ws + WS_WIN); bf16* Wout_t = (bf16*)(ws + WS_WOUT); bf16* Wgu_t = (bf16*)(ws + WS_WGU); bf16* Wd_t = (bf16*)(ws + WS_WD);
    for (int it = first + gw; it < last; it += NGW) {
        int r = it;
        if (r < I_IN) { const int nb = NIN / 32, k0 = 64 * (r / nb), n0 = 32 * (r % nb); p0_transpose_item(a.in[2], D, NIN, Win_t, k0, n0, n0, scr, F.lane, a.in[1]); continue; } r -= I_IN;
        if (r < I_OUT) { const int nb = D / 32, k0 = 64 * (r / nb), n0 = 32 * (r % nb); p0_transpose_item(a.in[7], D, D, Wout_t, k0, n0, n0, scr, F.lane); continue; } r -= I_OUT;
        if (r < I_G) { const int nb = DFF / 32, k0 = 64 * (r / nb), n0 = 32 * (r % nb); p0_transpose_item(a.in[9], D, DFF, Wgu_t, k0, n0, 256 * (n0 / 128) + (n0 % 128), scr, F.lane, a.in[8], n0 >= GU_FULL / 2 ? 0 : -1); continue; } r -= I_G;
        if (r < I_G) { const int nb = DFF / 32, k0 = 64 * (r / nb), n0 = 32 * (r % nb); p0_transpose_item(a.in[10], D, DFF, Wgu_t, k0, n0, 256 * (n0 / 128) + 128 + (n0 % 128), scr, F.lane, a.in[8], n0 >= GU_FULL / 2 ? 1 : -1); continue; } r -= I_G;
        { const int nb = D / 32, k0 = 64 * (r / nb), n0 = 32 * (r % nb); p0_transpose_item(a.in[11], DFF, D, Wd_t, k0, n0, n0, scr, F.lane); }
    }
}
__device__ __forceinline__ void p0_prologue(Frame& F, const Args& a) {
    const int gw = F.vcu * NWAVES + F.wave, NGW = F.G * NWAVES;
    unsigned char* ws = a.ws;
    convert_items(F, a, 0, I_IN, gw, NGW);
    { float* cs = (float*)(ws + WS_CS); const int gt = F.vcu * (NWAVES * 64) + F.tid;
      if (gt < SEQ * 8) { const int pos = gt >> 3, i = gt & 7; const float inv_freq = powf(500000.0f, -(float)i * 0.125f); float sn, c; sincosf((float)pos * inv_freq, &sn, &c);
          pg8::st4_wt(cs + pos * 16 + i, c); pg8::st4_wt(cs + pos * 16 + 8 + i, sn); } }
    bf16* XN = (bf16*)(ws + WS_XN);
    float* RS = (float*)(ws + WS_RS);
    for (int m = gw; m < M; m += NGW) row_to_bf16_rstd(F.lane, a.in[0] + (size_t)m * D, XN + (size_t)m * D, RS + m);
}

__device__ __forceinline__ void ho_arrive(gu32* cnt, int tid) {
    VM_WAIT(); __syncthreads();
    if (tid == 0) (void)__hip_atomic_fetch_add(cnt, 1u, RLX_AGENT);
}
__device__ __forceinline__ void ho_wait2(gu32* c0, unsigned w0, gu32* c1, unsigned w1, gu32* tmo, int wave, int lane) {
    if (wave == 0) {
        unsigned sp = 0;
        while (__hip_atomic_load(c0, RLX_AGENT) < w0 || __hip_atomic_load(c1, RLX_AGENT) < w1) { __builtin_amdgcn_s_sleep(2); if (++sp > (1u << 21)) { if (lane == 0) __hip_atomic_store(tmo, 1u, RLX_AGENT); break; } }
        __builtin_amdgcn_fence(__ATOMIC_ACQUIRE, "agent"); VM_WAIT();
    }
    __syncthreads();
}

static __device__ unsigned g_p0bar = 255u;
__global__ void __launch_bounds__(NWAVES * 64, 2) mega_fwd(Args args) {
    extern __shared__ __attribute__((aligned(16))) unsigned char lds[];
    Frame F;
    F.lds = (LAS unsigned char*)lds;
    F.MISC = (volatile LAS unsigned*)(F.lds + MISC_OFF);
    F.tid = threadIdx.x; F.lane = F.tid & 63; F.wave = __builtin_amdgcn_readfirstlane(F.tid >> 6);
    F.G = gridDim.x; { const int bx = blockIdx.x; F.vcu = (F.G % 8 == 0) ? (bx % 8) * (F.G / 8) + bx / 8 : bx; }
    unsigned char* ws = args.ws;
    F.ctl = (gu32*)(ws + WS_CTL);
    for (int u = F.tid; u < (LDS_BYTES - LDSCTL_OFF) / 4; u += NWAVES * 64) ((LAS unsigned*)(F.lds + LDSCTL_OFF))[u] = 0u;
    __syncthreads();
#if !SELFZERO
    XcdBarrier bar = xcd_barrier_post((unsigned*)(F.ctl + CW_BAR) + args.li * XCD_BAR_WORDS, F.MISC + 8);
#else
    XcdBarrier bar; bar.bar = (unsigned*)(F.ctl + CW_BAR); bar.x = 0u; bar.st = F.MISC + 8;
#endif
#ifdef PROBE_BAR2
#define GRID_BAR() do { xcd_barrier(bar); xcd_barrier(bar); xcd_barrier(bar); } while (0)
#else
#define GRID_BAR() xcd_barrier(bar)
#endif
    const int lo = args.ph_lo, hi = args.ph_hi;
#define IN(k) (lo <= (k) && (k) < hi)
#define BOTH(k) (IN(k) && IN((k) + 1))
    bf16* Win_t = (bf16*)(ws + WS_WIN); bf16* Wout_t = (bf16*)(ws + WS_WOUT); bf16* Wgu_t = (bf16*)(ws + WS_WGU); bf16* Wd_t = (bf16*)(ws + WS_WD);
    bf16* OB = (bf16*)(ws + WS_O); bf16* XN = (bf16*)(ws + WS_XN); bf16* PROJ = (bf16*)(ws + WS_PROJ); bf16* HB = (bf16*)(ws + WS_H);
    float* SS = (float*)(ws + WS_SS);

#if SELFZERO
    if (IN(0)) {
        p0_prologue(F, args);
        for (int i = (int)blockIdx.x * (NWAVES * 64) + F.tid; i < (int)(CTL_ZERO_BYTES / 4); i += F.G * (NWAVES * 64)) if (i != CW_P0BAR) pg8::st4_wt((void*)(F.ctl + i), 0.0f);
        for (int i = (int)blockIdx.x * (NWAVES * 64) + F.tid; i < M * 4 * 2; i += F.G * (NWAVES * 64)) pg8::st4_wt((void*)((float*)(ws + WS_XB) + i), 0.0f);
        VM_WAIT(); __syncthreads();
        if (F.wave == 0) {
            if (F.lane == 0) (void)atomicInc(&g_p0bar, (unsigned)F.G - 1u);
            unsigned sp = 0;
            while (__hip_atomic_load(&g_p0bar, RLX_AGENT) != (unsigned)F.G - 1u) { __builtin_amdgcn_s_sleep(2); if (++sp > (1u << 21)) { if (F.lane == 0) __hip_atomic_store(F.ctl + CW_TMO, 1u, RLX_AGENT); break; } }
            __builtin_amdgcn_fence(__ATOMIC_ACQUIRE, "agent"); VM_WAIT();
        }
        __syncthreads();
    }
#else
    if (IN(0)) { p0_prologue(F, args); if (BOTH(0)) GRID_BAR(); }
#endif

    if (IN(1)) {
        pg8::Gemm g{XN, Win_t, M, NIN, D}; pg8::RoundOrder S; S.init(M, NIN, F.G, (int)blockIdx.x); S.r0 = 0; S.r1 = 2;
        LAS float* csl = (LAS float*)(F.lds + att::LDS_SCR);
        { pg8::Unit u0; if (S.next(0, u0)) { const f32x4* src = (const f32x4*)(ws + WS_CS) + (size_t)((u0.pm * 256) & (SEQ - 1)) * 4;
              for (int i = F.tid; i < 256 * 4; i += NWAVES * 64) ((LAS f32x4*)csl)[i] = src[i];
              if (F.tid < 256) csl[256 * 16 + F.tid] = ((const float*)(ws + WS_RS))[u0.pm * 256 + F.tid]; }
          LDS_WAIT(); __syncthreads(); }
        pg8::EpiQKV<true> E{PROJ, NIN, csl};
        const int hn_units = 2 * ((M / 256) * (NIN / 256) - 2 * F.G);
        const bool hn_next = false && IN(2) && (int)blockIdx.x < hn_units;
        const char* tailB = hn_next ? (const char*)(Win_t + (size_t)(2048 + 128 * (((int)blockIdx.x >> 3) >> 3)) * D) : nullptr;
        pg8::gemm_phase<pg8::EpiQKV<true>, pg8::RoundOrder, PG8_ALIGN, PG8_SP2>(F.lds + RING_OFF, g, S, E, tailB);
        ho_arrive(F.ctl + CW_BATCH + args.li * 1024 + 64 * ((int)blockIdx.x & 7), F.tid);
    }

    if (IN(2)) {
        const unsigned long long tp0 = ATT_STAMP();
        const int n3 = 2 * ((M / 256) * (NIN / 256) - 2 * F.G);
        if (!(PROBE_ATTN_ONLY && args.li != 0))
        {   const int c = (int)blockIdx.x;
            if (c < n3) {
                const int half = (c >> 3) >> 3, pm3 = 8 * (c & 7) + ((c >> 3) & 7);
                LAS float* csl = (LAS float*)(F.lds + att::LDS_SCR);
                if (!IN(1)) { const f32x4* src = (const f32x4*)(ws + WS_CS) + (size_t)((pm3 * 256) & (SEQ - 1)) * 4;
                  for (int i = F.tid; i < 256 * 4; i += NWAVES * 64) ((LAS f32x4*)csl)[i] = src[i];
                  if (F.tid < 256) csl[256 * 16 + F.tid] = ((const float*)(ws + WS_RS))[pm3 * 256 + F.tid];
                  LDS_WAIT(); __syncthreads(); }
                pg8::Gemm g{XN, Win_t + (size_t)(2048 + 128 * half) * D, M, NIN, D}; pg8::OneUnit S{pm3};
                pg8::EpiKVHalf E{PROJ, NIN, csl, 2048 + 128 * half, half == 0};
                pg8::gemm_phase<pg8::EpiKVHalf, pg8::OneUnit, false, true, true>(F.lds + RING_OFF, g, S, E, nullptr, false);
                VM_WAIT(); __syncthreads();
                if (F.tid == 0) (void)__hip_atomic_fetch_add(F.ctl + CW_GATE + args.li * 1024 + 64 * (c & 7), 1u, RLX_AGENT);
            } else { convert_items(F, args, I_IN, NITEMS, (c - n3) * NWAVES + F.wave, (F.G - n3) * NWAVES); ho_arrive(F.ctl + args.li * 16384 + CW_WCONV, F.tid); }
        }
        LDS_WAIT(); __syncthreads();
        att::attn_setup(F.lds, args.in[3], args.in[5], args.in[6], F.tid);
        ho_wait2(F.ctl + CW_BATCH + args.li * 1024 + 64 * ((int)blockIdx.x & 7), IN(1) ? 32u : 0u, F.ctl + CW_BATCH + args.li * 1024 + 64 * ((int)blockIdx.x & 7), 0u, F.ctl + CW_TMO, F.wave, F.lane);
        const unsigned long long tp1 = ATT_STAMP();
        bool gate_open = false;
        {
            const unsigned qx = (unsigned)blockIdx.x & 7u;
            gu32* qhead = F.ctl + CW_QUEUE + args.li * 1024 + 64 * qx;
            unsigned nxt = 0u;
            if (F.tid == 0) nxt = __hip_atomic_fetch_add(qhead, 1u, RLX_AGENT);
            for (;;) {
                if (F.tid == 0) F.MISC[16] = nxt;
                LDS_WAIT(); __syncthreads();
                const unsigned slot = F.MISC[16];
                LDS_WAIT(); __syncthreads();
                if (slot >= 64u) break;
                if (F.tid == 0) nxt = __hip_atomic_fetch_add(qhead, 1u, RLX_AGENT);
                if (PROBE_ATTN_ONLY >= 2 && args.li != 0 && ((slot < 32u) != (PROBE_ATTN_ONLY == 2))) continue;
                const int upanel = (int)((qx * 32u + (slot & 31u)) >> 2);
                if (slot < 32u) att::attn_unit<true>(F.lds, PROJ, OB, args.in[5], args.in[4], (int)(qx * 32u + slot), F.wave, F.lane, args.li != 0 ? PROBE_DBG : 0);
                else {
                    if (!gate_open) {
                        if (F.wave == 0) { unsigned sp = 0; while (__hip_atomic_load(F.ctl + CW_GATE + args.li * 1024 + 64 * qx, RLX_AGENT) < ((PROBE_ATTN_ONLY && args.li != 0) ? 0u : (unsigned)(n3 / 8))) { __builtin_amdgcn_s_sleep(2);
                                if (++sp > (1u << 22)) { if (F.lane == 0) __hip_atomic_store(F.ctl + CW_TMO, 1u, RLX_AGENT); break; } }
                            __builtin_amdgcn_fence(__ATOMIC_ACQUIRE, "agent"); VM_WAIT(); }
                        __syncthreads(); gate_open = true;
                    }
                    att::attn_unit<false>(F.lds, PROJ, OB, args.in[6], args.in[4], (int)(qx * 32u + slot - 32u), F.wave, F.lane, args.li != 0 ? PROBE_DBG : 0);
                }
                ho_arrive(F.ctl + args.li * 16384 + CW_PAN_ATT + 64 * upanel, F.tid);
            }
        }
        if (DIAG && args.li == 0) { const unsigned long long tp2 = ATT_STAMP();
            if (blockIdx.x == DIAG_BLOCK && F.tid == 0) { volatile LAS unsigned* D_ = (volatile LAS unsigned*)(F.lds + MISC_OFF + 80); D_[5] = (unsigned)(tp1 - tp0); D_[6] = (unsigned)(tp2 - tp1);
                unsigned* dg = (unsigned*)(ws + WS_CS + 512 * 1024); D_[7] = D_[8] + D_[9] + D_[10] + D_[11];
                dg[0] = (unsigned)((DIAG_Q * 1ull * D_[DIAG_A0]) / (D_[DIAG_A1] ? D_[DIAG_A1] : 1u)); dg[1] = (unsigned)((DIAG_Q * 1ull * D_[DIAG_B0]) / (D_[DIAG_B1] ? D_[DIAG_B1] : 1u)); } }
        if (BOTH(2) && !DATAFLOW) GRID_BAR();
    }

    int mypanel = 0; { pg8::StaticOrder S; S.init(M, D, F.G, (int)blockIdx.x); pg8::Unit u0; if (S.next(0, u0)) mypanel = u0.pm; }
    const unsigned nconv = (unsigned)(F.G - 2 * ((M / 256) * (NIN / 256) - 2 * F.G));
    if (IN(3)) {
        if (DATAFLOW) ho_wait2(F.ctl + args.li * 16384 + CW_PAN_ATT + 64 * mypanel, IN(2) ? 8u : 0u, F.ctl + args.li * 16384 + CW_WCONV, IN(2) ? nconv : 0u, F.ctl + CW_TMO, F.wave, F.lane);
        pg8::Gemm g{OB, Wout_t, M, D, D}; pg8::StaticOrder S; S.init(M, D, F.G, (int)blockIdx.x);
        pg8::EpiOutProj E{XN, SS, D, XN, D};
        pg8::gemm_phase<pg8::EpiOutProj, pg8::StaticOrder, false, PG8_SP2>(F.lds + RING_OFF, g, S, E);
        if (DATAFLOW) ho_arrive(F.ctl + args.li * 16384 + CW_PAN_P3 + 64 * mypanel, F.tid);
        else if (BOTH(3)) GRID_BAR();
    }

    if (IN(4)) {
        if (DATAFLOW) ho_wait2(F.ctl + args.li * 16384 + CW_PAN_P3 + 64 * mypanel, IN(3) ? 4u : 0u, F.ctl + args.li * 16384 + CW_WCONV, IN(2) ? nconv : 0u, F.ctl + CW_TMO, F.wave, F.lane);
        pg8::Gemm g{XN, Wgu_t, M, NGU, D}; pg8::StaticOrder S; S.init(M, GU_FULL, F.G, (int)blockIdx.x);
        LAS pg8::f32x2* rs = (LAS pg8::f32x2*)(F.lds + att::LDS_SCR);
        { pg8::Unit u0; if (S.next(0, u0) && F.tid < 256) { const float* p = SS + (size_t)(u0.pm * 256 + F.tid); float s = 0.f;
#pragma unroll
              for (int i = 0; i < 16; ++i) s += p[(size_t)i * pg8::SS_PITCH];
              const float r = 1.0f / sqrtf(s * (1.0f / D) + RMS_EPS); rs[F.tid] = (pg8::f32x2){-r * LOG2E, -LOG2E * sqrtf(s * (1.0f / D) + RMS_EPS)}; }
          LDS_WAIT(); __syncthreads(); }
        pg8::EpiSwiGLU E{HB, DFF, rs};
        pg8::gemm_phase<pg8::EpiSwiGLU, pg8::StaticOrder, PG8_ALIGN, PG8_SP2>(F.lds + RING_OFF, g, S, E, (const char*)(Wgu_t + (size_t)(GU_FULL + 128 * ((int)blockIdx.x >> 6)) * D));
        {
            const int hj = (int)blockIdx.x >> 6;
            pg8::Gemm g2{XN, Wgu_t + (size_t)(GU_FULL + 128 * hj) * D, M, NGU, D}; pg8::OneUnit S2{mypanel};
            pg8::EpiSwiGLUHalf E2{HB, DFF, rs, GU_FULL / 2 + 64 * hj};
            pg8::gemm_phase<pg8::EpiSwiGLUHalf, pg8::OneUnit, false, true, true>(F.lds + RING_OFF, g2, S2, E2, nullptr, true);
        }
        if (DATAFLOW) ho_arrive(F.ctl + args.li * 16384 + CW_PAN_P4 + 64 * mypanel, F.tid);
        else if (BOTH(4)) GRID_BAR();
    }

    if (IN(5)) {
        if (DATAFLOW) ho_wait2(F.ctl + args.li * 16384 + CW_PAN_P4 + 64 * mypanel, IN(4) ? 4u : 0u, F.ctl + args.li * 16384 + CW_WCONV, IN(2) ? nconv : 0u, F.ctl + CW_TMO, F.wave, F.lane);
        unsigned poison = (__hip_atomic_load(F.ctl + CW_TMO, RLX_AGENT) != 0u);
        poison |= __hip_atomic_load((gu32*)((const unsigned*)(F.ctl + CW_BAR) + XB_TMO) + args.li * XCD_BAR_WORDS, RLX_AGENT) != 0u;
        pg8::Gemm g{HB, Wd_t, M, D, DFF, 1}; pg8::StaticOrder S; S.init(M, D, F.G, (int)blockIdx.x);
        pg8::RmsStats st{(unsigned*)(ws + WS_XB), (unsigned*)(F.ctl + args.li * 16384 + CW_SEAM), (unsigned*)(F.ctl + CW_TMO), 0x700u};
        pg8::EpiDownFinal E{XN, D, args.out, D, args.in[12], st, poison, (const unsigned*)(ws + WS_CS + 512 * 1024)};
        pg8::gemm_phase<pg8::EpiDownFinal, pg8::StaticOrder, false, PG8_SP2>(F.lds + RING_OFF, g, S, E);
    }
#undef IN
#undef BOTH
#undef GRID_BAR
}

extern "C" void kernel_launch(void* const* d_in, const int* in_sizes, int n_in, void* d_out, int out_size, void* d_ws, size_t ws_size, hipStream_t stream) {
    static int grid = 0;
    if (grid == 0) {
        if (n_in != 13 || in_sizes[0] != M * D || out_size != M * D || ws_size < WS_END) { fprintf(stderr, "kernel_launch: unexpected shapes (n_in %d, in0 %d, out %d, ws %zu); nothing launched\n", n_in, n_in > 0 ? in_sizes[0] : -1, out_size, ws_size); grid = -1; return; }
        int dev = 0, cus = 0, per_cu = 0;
        if (hipGetDevice(&dev) != hipSuccess || hipDeviceGetAttribute(&cus, hipDeviceAttributeMultiprocessorCount, dev) != hipSuccess) { grid = -1; return; }
        if (hipFuncSetAttribute((const void*)mega_fwd, hipFuncAttributeMaxDynamicSharedMemorySize, LDS_BYTES) != hipSuccess) { fprintf(stderr, "kernel_launch: hipFuncSetAttribute failed\n"); grid = -1; return; }
        if (hipOccupancyMaxActiveBlocksPerMultiprocessor(&per_cu, (const void*)mega_fwd, NWAVES * 64, LDS_BYTES) != hipSuccess || per_cu < 1) { fprintf(stderr, "kernel_launch: occupancy query reports %d workgroups per CU\n", per_cu); (void)hipGetLastError(); grid = -1; return; }
        (void)hipGetLastError();
        grid = cus;
        if (grid != 256) fprintf(stderr, "kernel_launch: %d CUs; the fused final rmsnorm needs exactly 256 workgroups\n", grid);
    }
    if (grid < 0) return;
#if !SELFZERO
    (void)hipMemsetAsync((char*)d_ws + WS_CTL, 0, CTL_ZERO_BYTES, stream);
#endif
    Args a{};
    for (int i = 0; i < 13; ++i) a.in[i] = (const float*)d_in[i];
    a.out = (float*)d_out; a.ws = (unsigned char*)d_ws;
#if defined(PROBE_CHAIN)
    a.ph_lo = 0; a.ph_hi = N_PHASES; a.li = 0;
    hipLaunchKernelGGL(mega_fwd, dim3(grid), dim3(NWAVES * 64), LDS_BYTES, stream, a);
    a.ph_lo = PROBE_CHAIN; a.ph_hi = PROBE_CHAIN_END; a.li = 1;
    hipLaunchKernelGGL(mega_fwd, dim3(grid), dim3(NWAVES * 64), LDS_BYTES, stream, a);
#elif defined(PROBE_TWICE)
    a.ph_lo = 0; a.ph_hi = N_PHASES; a.li = 0;
    hipLaunchKernelGGL(mega_fwd, dim3(grid), dim3(NWAVES * 64), LDS_BYTES, stream, a);
    a.li = 1;
    hipLaunchKernelGGL(mega_fwd, dim3(grid), dim3(NWAVES * 64), LDS_BYTES, stream, a);
#elif PROBE_PH >= 0
    a.ph_lo = 0; a.ph_hi = PROBE_PH + 1; a.li = 0;
    hipLaunchKernelGGL(mega_fwd, dim3(grid), dim3(NWAVES * 64), LDS_BYTES, stream, a);
    a.ph_lo = PROBE_PH; a.ph_hi = N_PHASES; a.li = 1;
    hipLaunchKernelGGL(mega_fwd, dim3(grid), dim3(NWAVES * 64), LDS_BYTES, stream, a);
#else
    a.ph_lo = 0; a.ph_hi = N_PHASES; a.li = 0;
    hipLaunchKernelGGL(mega_fwd, dim3(grid), dim3(NWAVES * 64), LDS_BYTES, stream, a);
#endif
}
```
